# Optimizing an MI355X kernel written in HIP

```python
import math
import jax
import jax.numpy as jnp
from jax import lax
import numpy as np

D_MODEL = 4096
BATCH = 2
SEQ = 4096
DEPTH = 4

N_EVEN = (DEPTH + 1) // 2
N_ODD = DEPTH // 2
EPS = 1e-6
BLOCK = 128
HEAD_DIM = 128
A_HEADS = 16
A_KV_HEADS = 4
A_GROUP = A_HEADS // A_KV_HEADS
WINDOW = 128
ROPE_THETA = 500000.0
ROPE_DIM = HEAD_DIM // 4
S5_WIDTH = 1024
S5_GROUP = 16
S5_GROUPS = S5_WIDTH // S5_GROUP
S5_STATE = 64
C_HEADS = 16
LRU_WIDTH = 2048
LRU_BLOCKS = 16
LRU_BLOCK_DIM = LRU_WIDTH // LRU_BLOCKS
LRU_CONV = 4
LRU_C = 8.0
D_FF = 10240
FFN_CONV = 3
PLE_DIM = 256

A_Q = A_HEADS * HEAD_DIM
A_KV = A_KV_HEADS * HEAD_DIM
EVEN_IN = A_Q + 2 * A_KV + S5_WIDTH
EVEN_OUT = A_Q + S5_WIDTH
C_W = C_HEADS * HEAD_DIM
ODD_IN = 3 * C_W + 2 * LRU_WIDTH
ODD_OUT = C_W + LRU_WIDTH

kernel_name = 'hybrid_swa_s5_stickbreak_rglru_trunk'


def rmsnorm(x, g):
    xf = x.astype(jnp.float32)
    y = xf * lax.rsqrt(jnp.mean(xf * xf, axis=-1, keepdims=True) + EPS)
    return (y * g.astype(jnp.float32)).astype(x.dtype)


def causal_depthwise_conv(x, w, b):
    width, seq = w.shape[0], x.shape[1]
    xp = jnp.pad(x, ((0, 0), (width - 1, 0), (0, 0)))
    y = b
    for tap in range(width):
        y = y + xp[:, tap:tap + seq] * w[tap]
    return y


def partial_rope(x, positions):
    half = ROPE_DIM // 2
    inv = ROPE_THETA ** (-jnp.arange(half, dtype=jnp.float32) * (2.0 / ROPE_DIM))
    ang = positions.astype(jnp.float32)[:, :, None] * inv
    cos = jnp.cos(ang)[:, :, None, :]
    sin = jnp.sin(ang)[:, :, None, :]
    xr = x[..., :ROPE_DIM].astype(jnp.float32)
    x1, x2 = xr[..., :half], xr[..., half:]
    rot = jnp.concatenate([x1 * cos - x2 * sin, x2 * cos + x1 * sin], axis=-1).astype(x.dtype)
    return jnp.concatenate([rot, x[..., ROPE_DIM:]], axis=-1)


def sliding_window_attention(q, k, v, sinks):
    bsz, seq = q.shape[0], q.shape[1]
    nb = seq // BLOCK
    qb = q.reshape(bsz, nb, BLOCK, A_KV_HEADS, A_GROUP, HEAD_DIM)

    def banded(t):
        cur = t.reshape(bsz, nb, BLOCK, A_KV_HEADS, HEAD_DIM)
        prev = jnp.pad(cur, ((0, 0), (1, 0), (0, 0), (0, 0), (0, 0)))[:, :-1]
        return jnp.concatenate([prev, cur], axis=2)

    kb, vb = banded(k), banded(v)
    logits = jnp.einsum('bnqkgd,bnskd->bnkgqs', qb, kb,
                        preferred_element_type=jnp.float32) * (HEAD_DIM ** -0.5)
    qpos = jnp.arange(BLOCK)[:, None] + BLOCK
    kpos = jnp.arange(2 * BLOCK)[None, :]
    blk = jnp.arange(nb)[:, None, None]
    valid = (kpos <= qpos) & (qpos - kpos < WINDOW) & (blk * BLOCK - BLOCK + kpos >= 0)
    logits = jnp.where(valid[None, :, None, None, :, :], logits, -jnp.inf)
    sink = sinks.astype(jnp.float32).reshape(A_KV_HEADS, A_GROUP)[None, None, :, :, None, None]
    m = jnp.maximum(jnp.max(logits, axis=-1, keepdims=True), sink)
    w = jnp.exp(logits - m)
    probs = (w / (jnp.sum(w, axis=-1, keepdims=True) + jnp.exp(sink - m))).astype(v.dtype)
    out = jnp.einsum('bnkgqs,bnskd->bnqkgd', probs, vb)
    return out.reshape(bsz, seq, A_Q)


def s5_layer(u, lam_re, lam_im, log_dt, b_re, b_im, c_re, c_im, d_skip, glu_w, glu_b):
    bsz, seq = u.shape[0], u.shape[1]
    uf = u.astype(jnp.float32).reshape(bsz, seq, S5_GROUPS, S5_GROUP)
    dt = jnp.exp(log_dt.astype(jnp.float32))[:, None]
    lr = jnp.minimum(lam_re.astype(jnp.float32), -1e-4)
    li = lam_im.astype(jnp.float32)
    mag = jnp.exp(lr * dt)
    ab_re, ab_im = mag * jnp.cos(li * dt), mag * jnp.sin(li * dt)
    nr, ni = ab_re - 1.0, ab_im
    den = lr * lr + li * li
    f_re, f_im = (nr * lr + ni * li) / den, (ni * lr - nr * li) / den
    br, bi = b_re.astype(jnp.float32), b_im.astype(jnp.float32)
    bb_re = f_re[..., None] * br - f_im[..., None] * bi
    bb_im = f_re[..., None] * bi + f_im[..., None] * br
    xu_re = jnp.einsum('bsgp,gnp->bsgn', uf, bb_re)
    xu_im = jnp.einsum('bsgp,gnp->bsgn', uf, bb_im)
    a_re = jnp.broadcast_to(ab_re, xu_re.shape)
    a_im = jnp.broadcast_to(ab_im, xu_im.shape)

    def combine(left, right):
        ar1, ai1, hr1, hi1 = left
        ar2, ai2, hr2, hi2 = right
        return (ar2 * ar1 - ai2 * ai1, ar2 * ai1 + ai2 * ar1,
                ar2 * hr1 - ai2 * hi1 + hr2, ar2 * hi1 + ai2 * hr1 + hi2)

    _, _, h_re, h_im = lax.associative_scan(combine, (a_re, a_im, xu_re, xu_im), axis=1)
    y = (jnp.einsum('bsgn,gpn->bsgp', h_re, c_re.astype(jnp.float32))
         - jnp.einsum('bsgn,gpn->bsgp', h_im, c_im.astype(jnp.float32))
         + d_skip.astype(jnp.float32).reshape(S5_GROUPS, S5_GROUP) * uf)
    g = jax.nn.gelu(y.reshape(bsz, seq, S5_WIDTH))
    out = g * jax.nn.sigmoid(g @ glu_w.astype(jnp.float32) + glu_b.astype(jnp.float32))
    return out.astype(u.dtype)


def stick_breaking_attention(q, k, v):
    bsz, seq = q.shape[0], q.shape[1]
    scale = HEAD_DIM ** -0.5
    outs = []
    for i in range(seq // BLOCK):
        q0, L = i * BLOCK, (i + 1) * BLOCK
        z = jnp.einsum('bqhd,bshd->bhqs', q[:, q0:L], k[:, :L],
                       preferred_element_type=jnp.float32) * scale
        strict = jnp.arange(L)[None, :] < (q0 + jnp.arange(BLOCK))[:, None]
        log_beta = jax.nn.log_sigmoid(z)
        log_stay = jnp.where(strict, jax.nn.log_sigmoid(-z), 0.0)
        between = lax.cumsum(log_stay, axis=3, reverse=True) - log_stay
        w = jnp.where(strict, jnp.exp(log_beta + between), 0.0).astype(v.dtype)
        outs.append(jnp.einsum('bhqs,bshd->bqhd', w, v[:, :L]))
    return jnp.concatenate(outs, axis=1).reshape(bsz, seq, C_W)


def rglru_block(xr, xg, conv_w, conv_b, wa, ba, wx, bx, lam):
    bsz, seq = xr.shape[0], xr.shape[1]
    xc = causal_depthwise_conv(xr, conv_w, conv_b)
    xb = xc.reshape(bsz, seq, LRU_BLOCKS, LRU_BLOCK_DIM)
    r = jax.nn.sigmoid(jnp.einsum('bshi,hij->bshj', xb, wa) + ba).reshape(bsz, seq, LRU_WIDTH)
    ig = jax.nn.sigmoid(jnp.einsum('bshi,hij->bshj', xb, wx) + bx).reshape(bsz, seq, LRU_WIDTH)
    log_a = -LRU_C * r.astype(jnp.float32) * jax.nn.softplus(-lam.astype(jnp.float32))
    a = jnp.exp(log_a)
    drive = jnp.sqrt(-jnp.expm1(2.0 * log_a)) * (ig * xc).astype(jnp.float32)

    def combine(left, right):
        a1, h1 = left
        a2, h2 = right
        return a2 * a1, a2 * h1 + h2

    _, h = lax.associative_scan(combine, (a, drive), axis=1)
    return h.astype(xr.dtype) * jax.nn.gelu(xg)


def conv_ffn(n, w_up, conv_w, conv_b, w_down):
    h = causal_depthwise_conv(n @ w_up, conv_w, conv_b)
    g, u = jnp.split(h, 2, axis=-1)
    return (jax.nn.silu(g) * u) @ w_down


def _normal(key, shape, scale):
    return jax.random.normal(key, shape, jnp.float32) * scale


def setup_inputs(seed: int = 0) -> dict:
    key = jax.random.key(seed)
    ks = iter(jax.random.split(key, 48))
    f32 = jnp.float32
    x = _normal(next(ks), (BATCH, SEQ, D_MODEL), 1.0)
    p = _normal(next(ks), (DEPTH, BATCH, SEQ, PLE_DIM), 1.0)
    positions = (jax.random.randint(next(ks), (BATCH, 1), 0, 1024, jnp.int32)
                 + jnp.arange(SEQ, dtype=jnp.int32)[None, :])
    mix_norm = 1.0 + _normal(next(ks), (DEPTH, D_MODEL), 0.02)
    ffn_norm = 1.0 + _normal(next(ks), (DEPTH, D_MODEL), 0.02)
    ple_norm = 1.0 + _normal(next(ks), (DEPTH, D_MODEL), 0.02)
    final_norm = 1.0 + _normal(next(ks), (D_MODEL,), 0.02)
    ab_w_in = _normal(next(ks), (N_EVEN, D_MODEL, EVEN_IN), D_MODEL ** -0.5)
    ab_w_out = _normal(next(ks), (N_EVEN, EVEN_OUT, D_MODEL), EVEN_OUT ** -0.5)
    attn_sinks = _normal(next(ks), (N_EVEN, A_HEADS), 0.5)
    s5_lam_re = -0.5 + _normal(next(ks), (N_EVEN, S5_GROUPS, S5_STATE), 0.01)
    s5_lam_im = (math.pi * jnp.arange(S5_STATE, dtype=f32)
                 + _normal(next(ks), (N_EVEN, S5_GROUPS, S5_STATE), 0.01))
    s5_log_dt = jax.random.uniform(next(ks), (N_EVEN, S5_GROUPS), f32, math.log(1e-3), math.log(1e-1))
    s5_b_re = _normal(next(ks), (N_EVEN, S5_GROUPS, S5_STATE, S5_GROUP), (2 * S5_GROUP) ** -0.5)
    s5_b_im = _normal(next(ks), (N_EVEN, S5_GROUPS, S5_STATE, S5_GROUP), (2 * S5_GROUP) ** -0.5)
    s5_c_re = _normal(next(ks), (N_EVEN, S5_GROUPS, S5_GROUP, S5_STATE), S5_STATE ** -0.5)
    s5_c_im = _normal(next(ks), (N_EVEN, S5_GROUPS, S5_GROUP, S5_STATE), S5_STATE ** -0.5)
    s5_d = _normal(next(ks), (N_EVEN, S5_WIDTH), 1.0)
    s5_glu_w = _normal(next(ks), (N_EVEN, S5_WIDTH, S5_WIDTH), S5_WIDTH ** -0.5)
    s5_glu_b = _normal(next(ks), (N_EVEN, S5_WIDTH), 0.01)
    cd_w_in = _normal(next(ks), (N_ODD, D_MODEL, ODD_IN), D_MODEL ** -0.5)
    cd_w_out = _normal(next(ks), (N_ODD, ODD_OUT, D_MODEL), ODD_OUT ** -0.5)
    lru_conv_w = _normal(next(ks), (N_ODD, LRU_CONV, LRU_WIDTH), LRU_CONV ** -0.5)
    lru_conv_b = _normal(next(ks), (N_ODD, LRU_WIDTH), 0.01)
    lru_wa = _normal(next(ks), (N_ODD, LRU_BLOCKS, LRU_BLOCK_DIM, LRU_BLOCK_DIM), LRU_BLOCK_DIM ** -0.5)
    lru_ba = _normal(next(ks), (N_ODD, LRU_BLOCKS, LRU_BLOCK_DIM), 0.01)
    lru_wx = _normal(next(ks), (N_ODD, LRU_BLOCKS, LRU_BLOCK_DIM, LRU_BLOCK_DIM), LRU_BLOCK_DIM ** -0.5)
    lru_bx = _normal(next(ks), (N_ODD, LRU_BLOCKS, LRU_BLOCK_DIM), 0.01)
    a_pow_c = jax.random.uniform(next(ks), (N_ODD, LRU_WIDTH), f32, 0.9, 0.999)
    s = a_pow_c ** (1.0 / LRU_C)
    lru_lambda = jnp.log(s) - jnp.log1p(-s)
    ffn_w_up = _normal(next(ks), (DEPTH, D_MODEL, 2 * D_FF), D_MODEL ** -0.5)
    ffn_conv_w = _normal(next(ks), (DEPTH, FFN_CONV, 2 * D_FF), FFN_CONV ** -0.5)
    ffn_conv_b = _normal(next(ks), (DEPTH, 2 * D_FF), 0.01)
    ffn_w_down = _normal(next(ks), (DEPTH, D_FF, D_MODEL), D_FF ** -0.5)
    ple_w_gate = _normal(next(ks), (DEPTH, D_MODEL, D_MODEL), D_MODEL ** -0.5)
    ple_w_proj = _normal(next(ks), (DEPTH, PLE_DIM, D_MODEL), PLE_DIM ** -0.5)
    return {'x': x, 'p': p, 'positions': positions,
            'mix_norm': mix_norm, 'ffn_norm': ffn_norm, 'ple_norm': ple_norm, 'final_norm': final_norm,
            'ab_w_in': ab_w_in, 'ab_w_out': ab_w_out, 'attn_sinks': attn_sinks,
            's5_lam_re': s5_lam_re, 's5_lam_im': s5_lam_im, 's5_log_dt': s5_log_dt,
            's5_b_re': s5_b_re, 's5_b_im': s5_b_im, 's5_c_re': s5_c_re, 's5_c_im': s5_c_im,
            's5_d': s5_d, 's5_glu_w': s5_glu_w, 's5_glu_b': s5_glu_b,
            'cd_w_in': cd_w_in, 'cd_w_out': cd_w_out, 'lru_conv_w': lru_conv_w, 'lru_conv_b': lru_conv_b,
            'lru_wa': lru_wa, 'lru_ba': lru_ba, 'lru_wx': lru_wx, 'lru_bx': lru_bx, 'lru_lambda': lru_lambda,
            'ffn_w_up': ffn_w_up, 'ffn_conv_w': ffn_conv_w, 'ffn_conv_b': ffn_conv_b, 'ffn_w_down': ffn_w_down,
            'ple_w_gate': ple_w_gate, 'ple_w_proj': ple_w_proj}


def reference(x, p, positions, mix_norm, ffn_norm, ple_norm, final_norm,
              ab_w_in, ab_w_out, attn_sinks,
              s5_lam_re, s5_lam_im, s5_log_dt, s5_b_re, s5_b_im, s5_c_re, s5_c_im,
              s5_d, s5_glu_w, s5_glu_b,
              cd_w_in, cd_w_out, lru_conv_w, lru_conv_b, lru_wa, lru_ba, lru_wx, lru_bx, lru_lambda,
              ffn_w_up, ffn_conv_w, ffn_conv_b, ffn_w_down, ple_w_gate, ple_w_proj):
    bsz, seq = x.shape[0], x.shape[1]
    h = x
    for i in range(DEPTH):
        j = i // 2
        n = rmsnorm(h, mix_norm[i])
        if i % 2 == 0:
            q, k, v, u = jnp.split(n @ ab_w_in[j], [A_Q, A_Q + A_KV, A_Q + 2 * A_KV], axis=-1)
            q = partial_rope(q.reshape(bsz, seq, A_HEADS, HEAD_DIM), positions)
            k = partial_rope(k.reshape(bsz, seq, A_KV_HEADS, HEAD_DIM), positions)
            v = v.reshape(bsz, seq, A_KV_HEADS, HEAD_DIM)
            ya = sliding_window_attention(q, k, v, attn_sinks[j])
            yb = s5_layer(u, s5_lam_re[j], s5_lam_im[j], s5_log_dt[j], s5_b_re[j], s5_b_im[j],
                          s5_c_re[j], s5_c_im[j], s5_d[j], s5_glu_w[j], s5_glu_b[j])
            h = h + jnp.concatenate([ya, yb], axis=-1) @ ab_w_out[j]
        else:
            q, k, v, xr, xg = jnp.split(n @ cd_w_in[j],
                                        [C_W, 2 * C_W, 3 * C_W, 3 * C_W + LRU_WIDTH], axis=-1)
            yc = stick_breaking_attention(q.reshape(bsz, seq, C_HEADS, HEAD_DIM),
                                          k.reshape(bsz, seq, C_HEADS, HEAD_DIM),
                                          v.reshape(bsz, seq, C_HEADS, HEAD_DIM))
            yd = rglru_block(xr, xg, lru_conv_w[j], lru_conv_b[j], lru_wa[j], lru_ba[j],
                             lru_wx[j], lru_bx[j], lru_lambda[j])
            h = h + jnp.concatenate([yc, yd], axis=-1) @ cd_w_out[j]
        h = h + conv_ffn(rmsnorm(h, ffn_norm[i]), ffn_w_up[i], ffn_conv_w[i], ffn_conv_b[i], ffn_w_down[i])
        gate = jax.nn.sigmoid(rmsnorm(h, ple_norm[i]) @ ple_w_gate[i])
        h = h + gate * (p[i] @ ple_w_proj[i])
    return rmsnorm(h, final_norm)
```

```cpp
#include <hip/hip_runtime.h>
#include <cstdio>
#include <cstdint>
#include <cstddef>
namespace pg8 {
#define PG8_LAS __attribute__((address_space(3)))
typedef unsigned short bf16_t;
typedef short bf16x8 __attribute__((ext_vector_type(8)));
typedef float f32x4 __attribute__((ext_vector_type(4)));
typedef unsigned u32x4 __attribute__((ext_vector_type(4)));
constexpr int BM = 256, BK = 64, HALF = 128, HTB = HALF * BK * 2  , STAGE_BYTES = 8 * HTB, NXCD = 8, WGM = 8;

__host__ __device__ __forceinline__ int lds_byte(int r, int c) { const int st = (r >> 4) * 2 + (c >> 5), rr = r & 15, cc = c & 31, ob = rr * 64 + cc * 2; return st * 1024 + (ob ^ (((ob >> 9) & 1) << 5)); }
__host__ __device__ __forceinline__ void stage_rc(int b, int& R, int& C) { const int st = b / 1024, sb = b % 1024, swz = sb ^ (((sb >> 9) & 1) << 5); R = (st >> 1) * 16 + swz / 64; C = (st & 1) * 32 + (swz % 64) / 2; }
__host__ __device__ __forceinline__ int perm32(int rho) { const int n = rho >> 4, i = rho & 15; return 8 * (i >> 2) + 4 * n + (i & 3); }

struct Unit { int pm, pn; };
struct Gemm { const bf16_t* A; const bf16_t* Bt; int M, N, K; };

struct StaticOrder {
    int nM, nN, nwg, G, c;
    __host__ __device__ void init(int M, int N, int G_, int c_) { nM = M / BM; nN = N / BM; nwg = nM * nN; G = G_; c = c_; }
    __host__ __device__ bool next(int i, Unit& u) const {
        const long L = (long)i * G + c; if (L >= nwg) return false;
        int wgid = (int)L; { const int q = nwg / NXCD, r = nwg % NXCD, xcd = wgid % NXCD, off = wgid / NXCD; wgid = (xcd < r ? xcd * (q + 1) : r * (q + 1) + (xcd - r) * q) + off; }
        const int nig = WGM * nN, gid = wgid / nig, fm = gid * WGM, gsz = (nM - fm) < WGM ? (nM - fm) : WGM;
        u.pm = fm + ((wgid % nig) % gsz); u.pn = (wgid % nig) / gsz; return true;
    }
    __device__ __forceinline__ void a_ready(const Unit&) const {}
    __device__ __forceinline__ void done(const Unit&) const {}
};

__device__ __forceinline__ unsigned cvt_pk_bf16(float lo, float hi) { unsigned r; asm volatile("v_cvt_pk_bf16_f32 %0, %1, %2" : "=v"(r) : "v"(lo), "v"(hi)); return r; }
constexpr int MROWS = 8192;
typedef float f32x2v __attribute__((ext_vector_type(2)));
typedef __bf16 bf16x2v __attribute__((ext_vector_type(2)));
__device__ __forceinline__ unsigned pk2(float lo, float hi) { f32x2v v = {lo, hi}; bf16x2v b = __builtin_convertvector(v, bf16x2v); return __builtin_bit_cast(unsigned, b); }
__device__ __forceinline__ float bflo(unsigned w) { return __uint_as_float(w << 16); }
__device__ __forceinline__ float bfhi(unsigned w) { return __uint_as_float(w & 0xffff0000u); }
template <int MASK> __device__ __forceinline__ float swz_xor(float v) { static_assert(MASK > 0 && MASK < 32, "ds_swizzle bit mode"); return __int_as_float(__builtin_amdgcn_ds_swizzle(__float_as_int(v), (MASK << 10) | 0x1f)); }
__device__ __forceinline__ float add_xor32(float v) { const auto rr = __builtin_amdgcn_permlane32_swap(__float_as_uint(v), __float_as_uint(v), false, false); return __uint_as_float(rr[0]) + __uint_as_float(rr[1]); }
__device__ __forceinline__ float max_xor32(float v) { const auto rr = __builtin_amdgcn_permlane32_swap(__float_as_uint(v), __float_as_uint(v), false, false); return fmaxf(__uint_as_float(rr[0]), __uint_as_float(rr[1])); }
__device__ __forceinline__ float other_xor32(float v, int hi) { const auto rr = __builtin_amdgcn_permlane32_swap(__float_as_uint(v), __float_as_uint(v), false, false); return __uint_as_float(hi ? rr[0] : rr[1]); }
__device__ __forceinline__ void epi_lane(int& fr, int& fq) { unsigned z = 0u; asm volatile("" : "+s"(z)); const int l = (int)__builtin_amdgcn_mbcnt_hi(~0u, __builtin_amdgcn_mbcnt_lo(~0u, z)); fr = l & 15; fq = l >> 4; }
__device__ __forceinline__ float sigmoid_f(float x) { return __builtin_amdgcn_rcpf(1.0f + __expf(-x)); }
template <int PARTS = 2> __device__ __forceinline__ void rows_rstd(const float* ssq, int row0, int fq, float (&rs)[8]) {
#pragma unroll
    for (int h = 0; h < 2; ++h) {
        f32x4 v[4][4];
#pragma unroll
        for (int g = 0; g < 4; ++g) { const f32x4* p = (const f32x4*)(ssq + (unsigned)(row0 + h * HALF + g * 16) * 64u + (unsigned)(fq * 16));
#pragma unroll
            for (int q = 0; q < 4; ++q) v[g][q] = p[q]; }
        asm volatile("" :: "v"(v[0][0]), "v"(v[0][1]), "v"(v[0][2]), "v"(v[0][3]), "v"(v[1][0]), "v"(v[1][1]), "v"(v[1][2]), "v"(v[1][3]),
                           "v"(v[2][0]), "v"(v[2][1]), "v"(v[2][2]), "v"(v[2][3]), "v"(v[3][0]), "v"(v[3][1]), "v"(v[3][2]), "v"(v[3][3]));
#pragma unroll
        for (int g = 0; g < 4; ++g) { float t = 0.f;
#pragma unroll
            for (int q = 0; q < 4; ++q) { t += v[g][q][0]; t += v[g][q][1]; t += v[g][q][2]; t += v[g][q][3]; }
            t += swz_xor<16>(t); t = add_xor32(t); rs[h * 4 + g] = rsqrtf(t * (1.0f / 4096.0f) + 1e-6f); }
    }
}
typedef __attribute__((address_space(3))) float lds_f32;
__device__ __forceinline__ void rows_rstd_shared(const float* ssq, int rowbase, int wr, int wc, int fr, int fq, lds_f32* rl, float (&rs)[8]) {
    f32x4 v[2][4];
#pragma unroll
    for (int h = 0; h < 2; ++h) { const f32x4* p = (const f32x4*)(ssq + (unsigned)(rowbase + h * HALF + wc * 16 + fr) * 64u + (unsigned)(fq * 16));
#pragma unroll
        for (int q = 0; q < 4; ++q) v[h][q] = p[q]; }
    asm volatile("" :: "v"(v[0][0]), "v"(v[0][1]), "v"(v[0][2]), "v"(v[0][3]), "v"(v[1][0]), "v"(v[1][1]), "v"(v[1][2]), "v"(v[1][3]));
#pragma unroll
    for (int h = 0; h < 2; ++h) { float t = 0.f;
#pragma unroll
        for (int q = 0; q < 4; ++q) { t += v[h][q][0]; t += v[h][q][1]; t += v[h][q][2]; t += v[h][q][3]; }
        t += swz_xor<16>(t); t = add_xor32(t);
        if (fq == 0) rl[wr * 128 + h * 64 + wc * 16 + fr] = rsqrtf(t * (1.0f / 4096.0f) + 1e-6f); }
    asm volatile("s_waitcnt lgkmcnt(0)\n\ts_barrier" ::: "memory");
#pragma unroll
    for (int h = 0; h < 2; ++h)
#pragma unroll
        for (int g = 0; g < 4; ++g) rs[h * 4 + g] = rl[wr * 128 + h * 64 + g * 16 + fr];
}
__device__ __forceinline__ float sumsq8(const f32x4& v0, const f32x4& v1) { return (v0[0] * v0[0] + v0[1] * v0[1]) + (v0[2] * v0[2] + v0[3] * v0[3]) + (v1[0] * v1[0] + v1[1] * v1[1]) + (v1[2] * v1[2] + v1[3] * v1[3]); }
__device__ __forceinline__ u32x4 pack8(const f32x4& v0, const f32x4& v1) { u32x4 w; w.x = pk2(v0[0], v0[1]); w.y = pk2(v0[2], v0[3]); w.z = pk2(v1[0], v1[1]); w.w = pk2(v1[2], v1[3]); return w; }
template <bool SCALE> struct EpiRowScale {
    static constexpr bool PERM = true, AFTER_DRAIN = false;
    bf16_t* O; int ldc; const float* ssq; lds_f32* rl;
    __device__ __forceinline__ void operator()(const f32x4 (&acc)[2][2][4][2], const Unit& u, int wr, int wc, int fr, int fq) const {
        epi_lane(fr, fq);
        const int row0 = u.pm * BM + wr * 64 + fr, col0 = u.pn * BM + wc * 32 + 8 * fq;
        float rs[8];
        if (SCALE) rows_rstd_shared(ssq, u.pm * BM + wr * 64, wr, wc, fr, fq, rl, rs);
#pragma unroll
        for (int ai = 0; ai < 2; ++ai)
#pragma unroll
            for (int m = 0; m < 4; ++m) {
                const int row = row0 + ai * HALF + m * 16;
                const float r1 = SCALE ? rs[ai * 4 + m] : 1.0f;
                bf16_t* rowp = O + (size_t)row * ldc + col0;
#pragma unroll
                for (int bj = 0; bj < 2; ++bj) *(u32x4*)(rowp + bj * HALF) = pack8(acc[ai][bj][m][0] * r1, acc[ai][bj][m][1] * r1);
            }
    }
};
__device__ __forceinline__ f32x4 unlo4(const u32x4& w) { f32x4 v; v[0] = bflo(w.x); v[1] = bfhi(w.x); v[2] = bflo(w.y); v[3] = bfhi(w.y); return v; }
__device__ __forceinline__ f32x4 unhi4(const u32x4& w) { f32x4 v; v[0] = bflo(w.z); v[1] = bfhi(w.z); v[2] = bflo(w.w); v[3] = bfhi(w.w); return v; }
struct EpiResidual {
    static constexpr bool PERM = true, AFTER_DRAIN = false;
    const bf16_t* hin; bf16_t* hb; float* ssq_out;
    __device__ __forceinline__ void operator()(const f32x4 (&acc)[2][2][4][2], const Unit& u, int wr, int wc, int fr, int fq) const {
        epi_lane(fr, fq);
        const int row0 = u.pm * BM + wr * 64 + fr, col0 = u.pn * BM + wc * 32 + 8 * fq, part = u.pn * 4 + wc;
        u32x4 hw[2][8];
#pragma unroll
        for (int bj = 0; bj < 2; ++bj)
#pragma unroll
            for (int g = 0; g < 8; ++g) { const unsigned off = (unsigned)(row0 + (g >> 2) * HALF + (g & 3) * 16) * 4096u + (unsigned)(col0 + bj * HALF); hw[bj][g] = *(const u32x4*)(hin + off); }
        float ss[8];
#pragma unroll
        for (int g = 0; g < 8; ++g) ss[g] = 0.f;
#pragma unroll
        for (int bj = 0; bj < 2; ++bj)
#pragma unroll
            for (int g = 0; g < 8; ++g) { const unsigned off = (unsigned)(row0 + (g >> 2) * HALF + (g & 3) * 16) * 4096u + (unsigned)(col0 + bj * HALF);
                const u32x4 w = pack8(unlo4(hw[bj][g]) + acc[g >> 2][bj][g & 3][0], unhi4(hw[bj][g]) + acc[g >> 2][bj][g & 3][1]);
                *(u32x4*)(hb + off) = w;
                ss[g] += sumsq8(unlo4(w), unhi4(w)); }
#pragma unroll
        for (int g = 0; g < 8; ++g) { float t = ss[g]; t += swz_xor<16>(t); t = add_xor32(t); if (fq == 0) ssq_out[(unsigned)(row0 + (g >> 2) * HALF + (g & 3) * 16) * 64u + (unsigned)part] = t; }
    }
};
struct EpiGate {
    static constexpr bool PERM = true, AFTER_DRAIN = false;
    const bf16_t* hin; bf16_t* hb; const float* ssq_in; float* ssq_out; const bf16_t* pe; lds_f32* rl;
    __device__ __forceinline__ f32x4 gate4(const f32x4& h, const f32x4& a, float r1, unsigned w0, unsigned w1) const {
        f32x4 v; v[0] = h[0] + sigmoid_f(a[0] * r1) * bflo(w0); v[1] = h[1] + sigmoid_f(a[1] * r1) * bfhi(w0); v[2] = h[2] + sigmoid_f(a[2] * r1) * bflo(w1); v[3] = h[3] + sigmoid_f(a[3] * r1) * bfhi(w1); return v; }
    __device__ __forceinline__ void operator()(const f32x4 (&acc)[2][2][4][2], const Unit& u, int wr, int wc, int fr, int fq) const {
        epi_lane(fr, fq);
        const int row0 = u.pm * BM + wr * 64 + fr, col0 = u.pn * BM + wc * 32 + 8 * fq, part = u.pn * 4 + wc;
        float rs[8]; rows_rstd_shared(ssq_in, u.pm * BM + wr * 64, wr, wc, fr, fq, rl, rs);
        float ss[8];
#pragma unroll
        for (int g = 0; g < 8; ++g) ss[g] = 0.f;
#pragma unroll
        for (int bj = 0; bj < 2; ++bj) {
            u32x4 hw[8], pw[8];
#pragma unroll
            for (int g = 0; g < 8; ++g) { const unsigned off = (unsigned)(row0 + (g >> 2) * HALF + (g & 3) * 16) * 4096u + (unsigned)(col0 + bj * HALF); hw[g] = *(const u32x4*)(hin + off); pw[g] = *(const u32x4*)(pe + off); }
#pragma unroll
            for (int g = 0; g < 8; ++g) { const unsigned off = (unsigned)(row0 + (g >> 2) * HALF + (g & 3) * 16) * 4096u + (unsigned)(col0 + bj * HALF);
                const u32x4 w = pack8(gate4(unlo4(hw[g]), acc[g >> 2][bj][g & 3][0], rs[g], pw[g].x, pw[g].y), gate4(unhi4(hw[g]), acc[g >> 2][bj][g & 3][1], rs[g], pw[g].z, pw[g].w));
                *(u32x4*)(hb + off) = w;
                ss[g] += sumsq8(unlo4(w), unhi4(w)); }
        }
#pragma unroll
        for (int g = 0; g < 8; ++g) { float t = ss[g]; t += swz_xor<16>(t); t = add_xor32(t); if (fq == 0) ssq_out[(unsigned)(row0 + (g >> 2) * HALF + (g & 3) * 16) * 64u + (unsigned)part] = t; }
    }
};
template <int CTRL> __device__ __forceinline__ float dpp_f(float v) { return __int_as_float(__builtin_amdgcn_update_dpp(0, __float_as_int(v), CTRL, 0xf, 0xf, true)); }
struct EpiUpConv {
    static constexpr bool PERM = true, AFTER_DRAIN = false;
    bf16_t* act; const float* ssq; const float* cw; const float* cb; float* halo; lds_f32* rl;
    static constexpr int NCH = 10240;
    __device__ __forceinline__ void operator()(const f32x4 (&acc)[2][2][4][2], const Unit& u, int wr, int wc, int fr, int fq) const {
        epi_lane(fr, fq);
        const int row0 = u.pm * BM + wr * 64 + fr, ch0 = u.pn * HALF + wc * 32 + 8 * fq;
        f32x4 cwv[2][8];
#pragma unroll
        for (int nh = 0; nh < 2; ++nh) {
            const int chn = ch0 + 4 * nh;
            cwv[nh][0] = *(const f32x4*)(cw + chn); cwv[nh][1] = *(const f32x4*)(cw + 2 * NCH + chn); cwv[nh][2] = *(const f32x4*)(cw + 4 * NCH + chn); cwv[nh][3] = *(const f32x4*)(cb + chn);
            cwv[nh][4] = *(const f32x4*)(cw + NCH + chn); cwv[nh][5] = *(const f32x4*)(cw + 3 * NCH + chn); cwv[nh][6] = *(const f32x4*)(cw + 5 * NCH + chn); cwv[nh][7] = *(const f32x4*)(cb + NCH + chn);
        }
        float rs[8]; rows_rstd_shared(ssq, u.pm * BM + wr * 64, wr, wc, fr, fq, rl, rs);
        unsigned keep[8][2];
#pragma unroll
        for (int nh = 0; nh < 2; ++nh) {
            const int chn = ch0 + 4 * nh;
            const f32x4 wg0 = cwv[nh][0], wg1 = cwv[nh][1], wg2 = cwv[nh][2], bg = cwv[nh][3];
            const f32x4 wu0 = cwv[nh][4], wu1 = cwv[nh][5], wu2 = cwv[nh][6], bu = cwv[nh][7];
#pragma unroll
            for (int ai = 0; ai < 2; ++ai) {
                f32x4 pg = {0.f, 0.f, 0.f, 0.f}, pu = {0.f, 0.f, 0.f, 0.f};
#pragma unroll
                for (int m = 0; m < 4; ++m) {
                    const int row = row0 + ai * HALF + m * 16; const float r1 = rs[ai * 4 + m];
                    const f32x4 g = acc[ai][0][m][nh] * r1, uu = acc[ai][1][m][nh] * r1;
                    f32x4 o;
#pragma unroll
                    for (int q = 0; q < 4; ++q) {
                        float gc = bg[q] + wg2[q] * g[q], uc = bu[q] + wu2[q] * uu[q];
                        asm("s_nop 1\n\t"
                            "v_fmac_f32_dpp %0, %2, %6 row_shr:1 row_mask:0xf bank_mask:0xf bound_ctrl:1\n\t"
                            "v_fmac_f32_dpp %0, %3, %6 row_shl:15 row_mask:0xf bank_mask:0xf bound_ctrl:1\n\t"
                            "v_fmac_f32_dpp %0, %2, %7 row_shr:2 row_mask:0xf bank_mask:0xf bound_ctrl:1\n\t"
                            "v_fmac_f32_dpp %0, %3, %7 row_shl:14 row_mask:0xf bank_mask:0xf bound_ctrl:1\n\t"
                            "v_fmac_f32_dpp %1, %4, %8 row_shr:1 row_mask:0xf bank_mask:0xf bound_ctrl:1\n\t"
                            "v_fmac_f32_dpp %1, %5, %8 row_shl:15 row_mask:0xf bank_mask:0xf bound_ctrl:1\n\t"
                            "v_fmac_f32_dpp %1, %4, %9 row_shr:2 row_mask:0xf bank_mask:0xf bound_ctrl:1\n\t"
                            "v_fmac_f32_dpp %1, %5, %9 row_shl:14 row_mask:0xf bank_mask:0xf bound_ctrl:1"
                            : "+v"(gc), "+v"(uc) : "v"(g[q]), "v"(pg[q]), "v"(uu[q]), "v"(pu[q]), "v"(wg1[q]), "v"(wg0[q]), "v"(wu1[q]), "v"(wu0[q]));
                        o[q] = gc * sigmoid_f(gc) * uc; }
                    if (m == 0 && fr < 2) {
                        float* hp = halo + ((size_t)((row >> 6) * 4 + fr) * 2) * NCH + chn; *(f32x4*)hp = g; *(f32x4*)(hp + NCH) = uu; }
                    if (nh == 0) { keep[ai * 4 + m][0] = pk2(o[0], o[1]); keep[ai * 4 + m][1] = pk2(o[2], o[3]); }
                    else if (!(m == 0 && fr < 2)) { u32x4 w; w.x = keep[ai * 4 + m][0]; w.y = keep[ai * 4 + m][1]; w.z = pk2(o[0], o[1]); w.w = pk2(o[2], o[3]); *(u32x4*)(act + (size_t)row * NCH + ch0) = w; }
                    if (m == 3 && fr >= 14) { float* hp = halo + ((size_t)((row >> 6) * 4 + (fr - 12)) * 2) * NCH + chn; *(f32x4*)hp = g; *(f32x4*)(hp + NCH) = uu; }
                    pg = g; pu = uu;
                }
            }
        }
    }
};
struct EpiGlu {
    static constexpr bool PERM = true, AFTER_DRAIN = false;
    const float* g; const float* bias; bf16_t* O; int ldc, coff;
    __device__ __forceinline__ void operator()(const f32x4 (&acc)[2][2][4][2], const Unit& u, int wr, int wc, int fr, int fq) const {
        epi_lane(fr, fq);
        const int row0 = u.pm * BM + wr * 64 + fr, col0 = u.pn * BM + wc * 32 + 8 * fq;
        f32x4 bv[2][2];
#pragma unroll
        for (int bj = 0; bj < 2; ++bj) { bv[bj][0] = *(const f32x4*)(bias + col0 + bj * HALF); bv[bj][1] = *(const f32x4*)(bias + col0 + bj * HALF + 4); }
#pragma unroll
        for (int ai = 0; ai < 2; ++ai)
#pragma unroll
            for (int m = 0; m < 4; ++m) {
                const int row = row0 + ai * HALF + m * 16;
#pragma unroll
                for (int bj = 0; bj < 2; ++bj) { const size_t goff = (size_t)row * 1024 + col0 + bj * HALF;
                    const f32x4 g0 = *(const f32x4*)(g + goff), g1 = *(const f32x4*)(g + goff + 4);
                    const f32x4 a0 = acc[ai][bj][m][0] + bv[bj][0], a1 = acc[ai][bj][m][1] + bv[bj][1];
                    f32x4 v0, v1;
#pragma unroll
                    for (int e = 0; e < 4; ++e) { v0[e] = g0[e] * sigmoid_f(a0[e]); v1[e] = g1[e] * sigmoid_f(a1[e]); }
                    u32x4 w; w.x = pk2(v0[0], v0[1]); w.y = pk2(v0[2], v0[3]); w.z = pk2(v1[0], v1[1]); w.w = pk2(v1[2], v1[3]);
                    *(u32x4*)(O + (size_t)row * ldc + coff + col0 + bj * HALF) = w; }
                asm volatile("" ::: "memory");
            }
    }
};
template <class Epi, class Sched, bool ALIGN_EPI = false, bool SP2 = false>
__device__ __forceinline__ void gemm_phase(PG8_LAS unsigned char* lds, const Gemm g, const Sched& S, const Epi& E, const int tid_in) {
    const int tid = tid_in, wid = __builtin_amdgcn_readfirstlane(tid >> 6), lane = tid & 63, wr = wid >> 2, wc = wid & 3, fr = lane & 15, fq = lane >> 4;
    const int K = g.K, nt = K / BK;
    unsigned voffA[2], voffB[2];
#pragma unroll
    for (int i = 0; i < 2; ++i) { int R, C; stage_rc(tid * 16 + i * 8192, R, C); const int Rb = Epi::PERM ? ((R & ~31) + perm32(R & 31)) : R;
        voffA[i] = (unsigned)(R * K + C) * 2u; voffB[i] = (unsigned)(Rb * K + C) * 2u; }
    const size_t kstep = (size_t)(BK * 2);
    const size_t hstep = (size_t)HALF * K * 2;
    const size_t tstep = 2 * hstep;
    const unsigned ldsw = (unsigned)wid * 1024u;
    const int aoff = lds_byte(wr * 64 + fr, fq * 8), boff = lds_byte(wc * 32 + fr, fq * 8);
#define PG8_SA(b, h) (((b) * 2 + (h)) * HTB)
#define PG8_SB(b, h) ((4 + (b) * 2 + (h)) * HTB)
#define PG8_STAGE(bufoff, gbase, voff) do { _Pragma("unroll") for (int _i = 0; _i < 2; ++_i) \
        __builtin_amdgcn_global_load_lds((const unsigned*)((const char*)(gbase) + (voff)[_i]), (PG8_LAS unsigned*)(lds + (bufoff) + ldsw + _i * 8192), 16, 0, 0); } while (0)
#define PG8_LDA(dst, b, h) do { _Pragma("unroll") for (int m = 0; m < 4; ++m) _Pragma("unroll") for (int k = 0; k < 2; ++k) dst[m][k] = *(const PG8_LAS bf16x8*)(lds + PG8_SA(b, h) + aoff + m * 2048 + k * 1024); } while (0)
#define PG8_LDB(dst, b, h) do { _Pragma("unroll") for (int n = 0; n < 2; ++n) _Pragma("unroll") for (int k = 0; k < 2; ++k) dst[n][k] = *(const PG8_LAS bf16x8*)(lds + PG8_SB(b, h) + boff + n * 2048 + k * 1024); } while (0)
#define PG8_MMA(ai, bj, At, Bt) do { __builtin_amdgcn_s_setprio(1); _Pragma("unroll") for (int m = 0; m < 4; ++m) _Pragma("unroll") for (int n = 0; n < 2; ++n) _Pragma("unroll") for (int k = 0; k < 2; ++k) \
        acc[ai][bj][m][n] = __builtin_amdgcn_mfma_f32_16x16x32_bf16(Bt[n][k], At[m][k], acc[ai][bj][m][n], 0, 0, 0); __builtin_amdgcn_s_setprio(0); } while (0)
#define PG8_WAIT_V(n) asm volatile("s_waitcnt vmcnt(" #n ")" ::: "memory")
#define PG8_WAIT_L(n) asm volatile("s_waitcnt lgkmcnt(" #n ")" ::: "memory")
#define PG8_BAR __builtin_amdgcn_s_barrier()
#define PG8_SCHED __builtin_amdgcn_sched_barrier(0)
    Unit cur, nxt; int ui = 0;
    if (!S.next(0, cur)) return;
    f32x4 acc[2][2][4][2];
#pragma unroll
    for (int a = 0; a < 2; ++a)
#pragma unroll
        for (int b = 0; b < 2; ++b)
#pragma unroll
            for (int m = 0; m < 4; ++m)
#pragma unroll
                for (int n = 0; n < 2; ++n) acc[a][b][m][n] = (f32x4){0.f, 0.f, 0.f, 0.f};
    bf16x8 At[4][2], B0[2][2], B1[2][2];
    const char* cA = (const char*)g.A + (size_t)cur.pm * tstep; const char* cB = (const char*)g.Bt + (size_t)cur.pn * tstep;
    S.a_ready(cur);
    if constexpr (SP2) {
        PG8_STAGE(PG8_SB(0, 0), cB, voffB); PG8_STAGE(PG8_SB(0, 1), cB + hstep, voffB); PG8_STAGE(PG8_SA(0, 0), cA, voffA); PG8_STAGE(PG8_SA(0, 1), cA + hstep, voffA);
        if (wr == 1) PG8_BAR;
        PG8_WAIT_V(2); PG8_BAR;
        PG8_STAGE(PG8_SB(1, 0), cB + kstep, voffB); PG8_STAGE(PG8_SA(1, 0), cA + kstep, voffA); PG8_STAGE(PG8_SB(1, 1), cB + hstep + kstep, voffB);
        PG8_WAIT_V(6); PG8_BAR;
    } else {
        PG8_STAGE(PG8_SB(0, 0), cB, voffB); PG8_STAGE(PG8_SA(0, 0), cA, voffA); PG8_STAGE(PG8_SB(0, 1), cB + hstep, voffB); PG8_STAGE(PG8_SA(0, 1), cA + hstep, voffA);
        if (wr == 1) PG8_BAR;
        PG8_WAIT_V(4); PG8_BAR;
        PG8_STAGE(PG8_SB(1, 0), cB + kstep, voffB); PG8_STAGE(PG8_SA(1, 0), cA + kstep, voffA); PG8_STAGE(PG8_SB(1, 1), cB + hstep + kstep, voffB);
        PG8_WAIT_V(6); PG8_BAR;
    }
    for (;;) {
        const bool has_next = S.next(ui + 1, nxt);
        const char* nA = has_next ? (const char*)g.A + (size_t)nxt.pm * tstep : cA; const char* nB = has_next ? (const char*)g.Bt + (size_t)nxt.pn * tstep : cB;
        for (int t = 0; t < nt; t += 2) {
            const bool last = (t == nt - 2);
            const char* a1 = cA + (size_t)(t + 1) * kstep;
            const char* a2 = last ? nA : cA + (size_t)(t + 2) * kstep; const char* b2 = last ? nB : cB + (size_t)(t + 2) * kstep;
            const char* a3 = a2 + kstep; const char* b3 = b2 + kstep;
            if (last && has_next) S.a_ready(nxt);
            if constexpr (SP2) {
            PG8_LDB(B0, 0, 0); PG8_LDB(B1, 0, 1); PG8_SCHED; PG8_LDA(At, 0, 0); PG8_STAGE(PG8_SA(1, 1), a1 + hstep, voffA);
            PG8_WAIT_V(8); PG8_WAIT_L(0); PG8_BAR; PG8_MMA(0, 0, At, B0); PG8_MMA(0, 1, At, B1); PG8_BAR; PG8_SCHED;
            PG8_LDA(At, 0, 1); PG8_STAGE(PG8_SB(0, 0), b2, voffB); PG8_STAGE(PG8_SB(0, 1), b2 + hstep, voffB); PG8_STAGE(PG8_SA(0, 0), a2, voffA);
            PG8_WAIT_V(8); PG8_WAIT_L(0); PG8_BAR; PG8_MMA(1, 0, At, B0); PG8_MMA(1, 1, At, B1); PG8_BAR; PG8_SCHED;
            PG8_LDB(B0, 1, 0); PG8_LDB(B1, 1, 1); PG8_SCHED; PG8_LDA(At, 1, 0); PG8_STAGE(PG8_SA(0, 1), a2 + hstep, voffA);
            PG8_WAIT_V(8); PG8_WAIT_L(0); PG8_BAR; PG8_MMA(0, 0, At, B0); PG8_MMA(0, 1, At, B1); PG8_BAR; PG8_SCHED;
            PG8_LDA(At, 1, 1); PG8_STAGE(PG8_SB(1, 0), b3, voffB); PG8_STAGE(PG8_SB(1, 1), b3 + hstep, voffB); PG8_STAGE(PG8_SA(1, 0), a3, voffA);
            PG8_WAIT_V(8); PG8_WAIT_L(0); PG8_BAR; PG8_MMA(1, 0, At, B0); PG8_MMA(1, 1, At, B1); PG8_BAR; PG8_SCHED;
            } else {
            PG8_LDB(B0, 0, 0); PG8_SCHED; PG8_LDA(At, 0, 0); PG8_STAGE(PG8_SA(1, 1), a1 + hstep, voffA);
            PG8_WAIT_L(8); PG8_BAR; PG8_WAIT_L(0); PG8_MMA(0, 0, At, B0); PG8_BAR; PG8_SCHED;
            PG8_LDB(B1, 0, 1); PG8_STAGE(PG8_SB(0, 0), b2, voffB);
            PG8_BAR; PG8_WAIT_L(0); PG8_MMA(0, 1, At, B1); PG8_BAR;
            PG8_LDA(At, 0, 1); PG8_STAGE(PG8_SA(0, 0), a2, voffA);
            PG8_BAR; PG8_WAIT_L(0); PG8_MMA(1, 0, At, B0); PG8_BAR; PG8_SCHED;
            PG8_STAGE(PG8_SB(0, 1), b2 + hstep, voffB);
            PG8_WAIT_V(6); PG8_BAR; PG8_MMA(1, 1, At, B1); PG8_BAR;
            PG8_LDB(B0, 1, 0); PG8_SCHED; PG8_LDA(At, 1, 0); PG8_STAGE(PG8_SA(0, 1), a2 + hstep, voffA);
            PG8_WAIT_L(8); PG8_BAR; PG8_WAIT_L(0); PG8_MMA(0, 0, At, B0); PG8_BAR; PG8_SCHED;
            PG8_LDB(B1, 1, 1); PG8_STAGE(PG8_SB(1, 0), b3, voffB);
            PG8_BAR; PG8_WAIT_L(0); PG8_MMA(0, 1, At, B1); PG8_BAR;
            PG8_LDA(At, 1, 1); PG8_STAGE(PG8_SA(1, 0), a3, voffA);
            PG8_BAR; PG8_WAIT_L(0); PG8_MMA(1, 0, At, B0); PG8_BAR; PG8_SCHED;
            PG8_STAGE(PG8_SB(1, 1), b3 + hstep, voffB);
            PG8_WAIT_V(6); PG8_BAR; PG8_MMA(1, 1, At, B1); PG8_BAR;
            }
        }
        if constexpr (ALIGN_EPI) { if (wr == 0) PG8_BAR; }
        if constexpr (!Epi::AFTER_DRAIN) { E(acc, cur, wr, wc, fr, fq); S.done(cur); }
        if (!has_next) break;
#pragma unroll
        for (int a = 0; a < 2; ++a)
#pragma unroll
            for (int b = 0; b < 2; ++b)
#pragma unroll
                for (int m = 0; m < 4; ++m)
#pragma unroll
                    for (int n = 0; n < 2; ++n) acc[a][b][m][n] = (f32x4){0.f, 0.f, 0.f, 0.f};
        cur = nxt; cA = nA; cB = nB; ++ui;
        if constexpr (ALIGN_EPI) { if (wr == 1) PG8_BAR; }
    }
    PG8_WAIT_V(0);
    if constexpr (!ALIGN_EPI) { if (wr == 0) PG8_BAR; }
    PG8_BAR;
    if constexpr (Epi::AFTER_DRAIN) { E.fused(acc, cur, wr, wc, fr, fq, lds, wid, lane); S.done(cur); }
#undef PG8_SA
#undef PG8_SB
#undef PG8_STAGE
#undef PG8_LDA
#undef PG8_LDB
#undef PG8_MMA
#undef PG8_WAIT_V
#undef PG8_WAIT_L
#undef PG8_BAR
#undef PG8_SCHED
}
}

constexpr int DM = 4096, BATCH = 2, SEQ = 4096, DEPTH = 4, M = BATCH * SEQ;
constexpr int HD = 128, A_HEADS = 16, A_KVH = 4, WINDOW = 128;
constexpr int A_Q = A_HEADS * HD, A_KV = A_KVH * HD, EVEN_IN = 4096, EVEN_OUT = 3072;
constexpr int S5_W = 1024, S5_P = 16, S5_NG = 64, S5_N = 64;
constexpr int C_HEADS = 16, C_W = 2048, ODD_IN = 10240, ODD_OUT = 4096;
constexpr int LRU_W = 2048, LRU_NB = 16, LRU_BD = 128;
constexpr int DFF = 10240, PLE = 256;
constexpr int NWAVES = 8, NTHREADS = NWAVES * 64;
constexpr int CHUNK = 64, NCHUNK = SEQ / CHUNK;
static_assert(M == pg8::MROWS, "rows");

constexpr size_t MiB = 1u << 20;
constexpr size_t WS_CTL = 0, CTL_ZERO_BYTES = 1 * MiB;
constexpr size_t WS_W_ABIN  = 1 * MiB;
constexpr size_t WS_W_ABOUT = WS_W_ABIN  + 2 * (size_t)EVEN_IN * DM * 2;
constexpr size_t WS_W_CDIN  = WS_W_ABOUT + 2 * (size_t)DM * EVEN_OUT * 2;
constexpr size_t WS_W_CDOUT = WS_W_CDIN  + 2 * (size_t)ODD_IN * DM * 2;
constexpr size_t WS_W_UP    = WS_W_CDOUT + 2 * (size_t)DM * ODD_OUT * 2;
constexpr size_t WS_W_DOWN  = WS_W_UP    + 4 * (size_t)(2 * DFF) * DM * 2;
constexpr size_t WS_W_GATE  = WS_W_DOWN  + 4 * (size_t)DM * DFF * 2;
constexpr size_t WS_W_PROJ  = WS_W_GATE  + 4 * (size_t)DM * DM * 2;
constexpr size_t WS_W_GLU   = WS_W_PROJ  + 4 * (size_t)DM * PLE * 2;
constexpr size_t WS_W_LRU   = WS_W_GLU   + 2 * (size_t)S5_W * S5_W * 2;
constexpr size_t WS_PB      = WS_W_LRU   + 2 * 2 * (size_t)LRU_BD * LRU_W * 2;
constexpr size_t WS_ROPE    = WS_PB      + (size_t)DEPTH * M * PLE * 2;
constexpr size_t WS_S5A     = WS_ROPE    + (size_t)M * 32 * 4;
constexpr size_t WS_S5B     = WS_S5A     + 2 * (size_t)4096 * 2 * 4;
constexpr size_t WS_H0      = WS_S5B     + 2 * (size_t)4096 * 32 * 4;
constexpr size_t WS_H1      = WS_H0      + (size_t)M * DM * 4;
constexpr size_t WS_HB0     = WS_H1      + (size_t)M * DM * 4;
constexpr size_t WS_HB1     = WS_HB0     + (size_t)M * DM * 2;
constexpr size_t WS_SSQ0    = WS_HB1     + (size_t)M * DM * 2;
constexpr size_t WS_SSQ1    = WS_SSQ0    + (size_t)64 * M * 4;
constexpr size_t WS_PROJ    = WS_SSQ1    + (size_t)64 * M * 4;
constexpr size_t WS_CAT     = WS_PROJ    + (size_t)M * ODD_IN * 2;
constexpr size_t WS_ACT     = WS_CAT     + (size_t)M * ODD_OUT * 2;
constexpr size_t WS_HALO    = WS_ACT     + (size_t)M * DFF * 2;
constexpr size_t WS_PE      = WS_HALO    + (size_t)(M / 64) * 4 * 2 * DFF * 4;
constexpr size_t WS_GF      = WS_PE      + (size_t)M * DM * 2;
constexpr size_t WS_GB      = WS_GF      + (size_t)M * S5_W * 4;
constexpr size_t WS_S5H     = WS_GB      + (size_t)M * S5_W * 2;
constexpr size_t WS_LGA     = WS_S5H     + (size_t)BATCH * S5_NG * NCHUNK * S5_N * 2 * 4;
constexpr size_t WS_LGX     = WS_LGA     + (size_t)M * LRU_W * 4;
constexpr size_t WS_LSUM    = WS_LGX     + (size_t)M * LRU_W * 4;
constexpr size_t WS_END     = WS_LSUM    + (size_t)BATCH * NCHUNK * LRU_W * 2 * 4;
static_assert(WS_W_ABIN % 256 == 0 && WS_H0 % 256 == 0 && WS_PROJ % 256 == 0 && WS_LSUM % 256 == 0, "alignment");
constexpr int CW_BAR = 4096, CW_SWA = 16384;

constexpr int RING_OFF = 0, RING_BYTES = 131072;
constexpr int MISC_OFF = 147456 - 512;
constexpr int LDS_BYTES = 147456;

#define GAS __attribute__((address_space(1)))
#define LAS __attribute__((address_space(3)))
typedef unsigned short bf16;
typedef unsigned v4u __attribute__((ext_vector_type(4)));
typedef unsigned v2u __attribute__((ext_vector_type(2)));
typedef float f32x4 __attribute__((ext_vector_type(4)));
typedef float f32x16 __attribute__((ext_vector_type(16)));
typedef short bf16x8 __attribute__((ext_vector_type(8)));
typedef short s16x4 __attribute__((ext_vector_type(4)));
typedef float f32x2w __attribute__((ext_vector_type(2)));
using pg8::pk2; using pg8::bflo; using pg8::bfhi; using pg8::sigmoid_f; using pg8::swz_xor; using pg8::add_xor32; using pg8::max_xor32; using pg8::other_xor32;
#define LDS_WAIT() asm volatile("s_waitcnt lgkmcnt(0)" ::: "memory")
__device__ __forceinline__ float bf2f(short s) { return __uint_as_float(((unsigned)(unsigned short)s) << 16); }
__device__ __forceinline__ short f2bfs(float a) { return (short)(pk2(a, 0.f) & 0xffffu); }
__device__ __forceinline__ float opaque_f(float v) { asm volatile("" : "+v"(v)); return v; }
__device__ __forceinline__ float gelu_tanh(float x, float half) {
    const float y = 0.7978845608028654f * (x + 0.044715f * x * x * x);
    const float t = 1.0f - 2.0f * __builtin_amdgcn_rcpf(__expf(2.0f * y) + 1.0f);
    return (half * x) * (1.0f + t);
}
#define XB_TMO      128
#define XB_XCNT(j)  (256  + 64 * (j))
#define XB_XSUB(j)  (1280 + 64 * (j))
#define XB_XGEN(j)  (2304 + 64 * (j))
#define XB_TOP      3328
#define XB_TOPGEN   3392
#define XCD_BAR_WORDS 3456
#define XB_SPIN_CAP (1u << 18)

__device__ __forceinline__ unsigned xb_ld(unsigned* p)              { return __hip_atomic_load(p, __ATOMIC_RELAXED, __HIP_MEMORY_SCOPE_AGENT); }
__device__ __forceinline__ unsigned xb_add(unsigned* p, unsigned v) { return __hip_atomic_fetch_add(p, v, __ATOMIC_RELAXED, __HIP_MEMORY_SCOPE_AGENT); }
__device__ __forceinline__ unsigned xb_xcc_id() { return (unsigned)__builtin_amdgcn_s_getreg((3 << 11) | 20) & 0xFu; }
#define XB_SPIN(cond, bar) do { unsigned _sp = 0; while (cond) { __builtin_amdgcn_s_sleep(1); \
    if ((++_sp & 255u) == 0u) { if (xb_ld(&(bar)[XB_TMO])) break; if (_sp > XB_SPIN_CAP) { atomicAdd(&(bar)[XB_TMO], 1u); break; } } } } while (0)

struct XcdBarrier {
    unsigned* bar; unsigned x;
    volatile LAS unsigned* st;
};

__device__ __forceinline__ XcdBarrier xcd_barrier_post(unsigned* bar, volatile LAS unsigned* st) {
    XcdBarrier b; b.bar = bar; b.x = xb_xcc_id(); b.st = st;
    if (threadIdx.x == 0) (void)xb_add(&bar[XB_XCNT(b.x)], 1u);
    return b;
}
__device__ __forceinline__ void xcd_barrier_complete(unsigned* bar, unsigned x, unsigned& nloc, unsigned& nx) {
    const unsigned G = gridDim.x * gridDim.y * gridDim.z;
    unsigned sum, cnt, mine, sp = 0u;
    for (;;) {
        sum = 0u; cnt = 0u; mine = 0u;
#pragma unroll
        for (unsigned j = 0; j < 16; ++j) { const unsigned c = xb_ld(&bar[XB_XCNT(j)]); sum += c; cnt += (c > 0u) ? 1u : 0u; mine = (j == x) ? c : mine; }
        if (sum == G) break;
        __builtin_amdgcn_s_sleep(1);
        if ((++sp & 255u) == 0u) { if (xb_ld(&bar[XB_TMO])) break; if (sp > XB_SPIN_CAP) { atomicAdd(&bar[XB_TMO], 1u); break; } }
    }
    nloc = mine > 0u ? mine : 1u; nx = cnt > 0u ? cnt : 1u;
}

__device__ __forceinline__ void xcd_barrier(const XcdBarrier& b) {
    asm volatile("s_waitcnt vmcnt(0)" ::: "memory");
    __syncthreads();
    if (threadIdx.x == 0) {
        unsigned* bar = b.bar;
        __builtin_amdgcn_s_waitcnt(0);
        unsigned nloc = b.st[0], nx = b.st[1];
        if (nloc == 0u) { xcd_barrier_complete(bar, b.x, nloc, nx); b.st[0] = nloc; b.st[1] = nx; }
        const unsigned old = xb_add(&bar[XB_XSUB(b.x)], 1u);
        const unsigned gen = old / nloc;
        if (old + 1u == (gen + 1u) * nloc) {
            __builtin_amdgcn_fence(__ATOMIC_RELEASE, "agent");
            asm volatile("s_waitcnt vmcnt(0)" ::: "memory");
            const unsigned og = xb_add(&bar[XB_TOP], 1u);
            const unsigned tg = og / nx;
            if (og + 1u == (tg + 1u) * nx) xb_add(&bar[XB_TOPGEN], 1u);
            else XB_SPIN(xb_ld(&bar[XB_TOPGEN]) == tg, bar);
            __builtin_amdgcn_fence(__ATOMIC_ACQUIRE, "agent");
            xb_add(&bar[XB_XGEN(b.x)], 1u);
            asm volatile("s_waitcnt vmcnt(0)" ::: "memory");
        } else {
            XB_SPIN(xb_ld(&bar[XB_XGEN(b.x)]) == gen, bar);
            __builtin_amdgcn_fence(__ATOMIC_ACQUIRE, "agent");
            asm volatile("s_waitcnt vmcnt(0)" ::: "memory");
        }
    }
    __syncthreads();
}


struct Ctx {
    LAS unsigned char* lds;
    LAS unsigned char* wl;
    int tid, lane, wave;
    int gw, ngw;
    int gt, ngt;
};

__device__ __forceinline__ Ctx make_ctx(LAS unsigned char* lds_base, int wave_id) {
    Ctx C; unsigned zero = 0u; asm volatile("" : "+s"(zero));
    const int lane = (int)__builtin_amdgcn_mbcnt_hi(~0u, __builtin_amdgcn_mbcnt_lo(~0u, zero));
    C.lds = lds_base; C.lane = lane; C.wave = wave_id; C.tid = wave_id * 64 + lane;
    C.wl = C.lds + RING_OFF + C.wave * 16384;
    const int G = gridDim.x;
    C.gw = blockIdx.x * NWAVES + C.wave; C.ngw = G * NWAVES; C.gt = blockIdx.x * NTHREADS + C.tid; C.ngt = G * NTHREADS;
    return C;
}
__device__ __forceinline__ unsigned char* launder_u8(unsigned char* p) { size_t z = 0; asm volatile("" : "+s"(z)); return p + z; }
#define INP(k) ((const float*)(const GAS float*)in[k])

constexpr int TP_PITCH = 66, TP_BYTES = 64 * TP_PITCH * 4;
__device__ __forceinline__ void p0_transpose_item(const float* W, int K, int N, bf16* WT, const float* gain, LAS unsigned* scr, int item, int lane, bool up_perm) {
    const int nblk = N / 64, kb = item / nblk, nb = item % nblk, k0 = 128 * kb, n0 = 64 * nb;
    const int n0d = !up_perm ? n0 : (n0 < DFF ? (n0 / 128) * 256 + (n0 % 128) : ((n0 - DFF) / 128) * 256 + 128 + ((n0 - DFF) % 128));
    const float* src = W + (size_t)k0 * N + n0 + lane;
    float g0 = 1.f, g1 = 1.f; if (gain) { g0 = gain[k0 + lane]; g1 = gain[k0 + 64 + lane]; }
#pragma unroll
    for (int bt = 0; bt < 4; ++bt) {
        float v[32];
#pragma unroll
        for (int i = 0; i < 32; ++i) v[i] = __builtin_nontemporal_load(src + (size_t)(32 * bt + i) * N);
#pragma unroll
        for (int i = 0; i < 16; ++i) { const int k = 32 * bt + 2 * i;
            const float ga = __uint_as_float(__builtin_amdgcn_readlane(__float_as_uint(k < 64 ? g0 : g1), k & 63)), gb = __uint_as_float(__builtin_amdgcn_readlane(__float_as_uint(k < 64 ? g0 : g1), (k + 1) & 63));
            scr[(16 * bt + i) * TP_PITCH + lane] = pk2(v[2 * i] * ga, v[2 * i + 1] * gb); }
    }
    LDS_WAIT(); asm volatile("" ::: "memory");
#pragma unroll
    for (int ps = 0; ps < 2; ++ps)
#pragma unroll
        for (int j = 0; j < 8; ++j) { const int n = (lane & 7) + 8 * j, c = (lane >> 3) + 8 * ps; const LAS unsigned* s = scr + (4 * c) * TP_PITCH + n;
            v4u o; o.x = s[0]; o.y = s[TP_PITCH]; o.z = s[2 * TP_PITCH]; o.w = s[3 * TP_PITCH];
            *(v4u*)(WT + (size_t)(n0d + n) * K + k0 + 8 * c) = o; }
    LDS_WAIT(); asm volatile("" ::: "memory");
}

__device__ const float ROPE_INV[16] = {
    1.000000000e+00f, 4.403665960e-01f, 1.939227432e-01f, 8.539710194e-02f, 3.760603070e-02f, 1.656044088e-02f, 7.292664610e-03f, 3.211446106e-03f,
    1.414213562e-03f, 6.227724371e-04f, 2.742481884e-04f, 1.207697351e-04f, 5.318295734e-05f, 2.341999971e-05f, 1.031338525e-05f, 4.541670478e-06f };

__device__ __forceinline__ void sincos_acc(float ang, float& s, float& c) {
    double r = (double)ang * 0.15915494309189535;
    r -= __builtin_rint(r);
    const float rf = (float)r;
    s = __builtin_amdgcn_sinf(rf); c = __builtin_amdgcn_cosf(rf);
}

__device__ __forceinline__ void p0_prologue(const Ctx& C, const float* const* in, unsigned char* ws) {
    LAS unsigned* scr = (LAS unsigned*)(C.lds + C.wave * TP_BYTES);
    {
        constexpr int I_ABIN = (DM / 128) * (EVEN_IN / 64), I_ABOUT = (EVEN_OUT / 128) * (DM / 64), I_CDIN = (DM / 128) * (ODD_IN / 64), I_CDOUT = (ODD_OUT / 128) * (DM / 64);
        constexpr int I_UP = (DM / 128) * (2 * DFF / 64), I_DOWN = (DFF / 128) * (DM / 64), I_GATE = (DM / 128) * (DM / 64), I_PROJ = (PLE / 128) * (DM / 64);
        constexpr int I_GLU = (S5_W / 128) * (S5_W / 64), I_LRU = (LRU_W / 128) * (LRU_BD / 64);
        constexpr int NITEMS = 2 * (I_ABIN + I_ABOUT + I_CDIN + I_CDOUT + I_GLU + 2 * I_LRU) + 4 * (I_UP + I_DOWN + I_GATE + I_PROJ);
        for (int it = C.gw; it < NITEMS; it += C.ngw) {
            int r = it; const float* src; bf16* dst; const float* gain = nullptr; int K, N, idx; bool up_perm = false;
            if (r < 4 * I_UP) { idx = r / I_UP; r -= idx * I_UP; K = DM; N = 2 * DFF; src = INP(29) + (size_t)idx * DM * 2 * DFF; dst = (bf16*)(ws + WS_W_UP) + (size_t)idx * 2 * DFF * DM; gain = INP(4) + idx * DM; up_perm = true; }
            else { r -= 4 * I_UP;
            if (r < 4 * I_DOWN) { idx = r / I_DOWN; r -= idx * I_DOWN; K = DFF; N = DM; src = INP(32) + (size_t)idx * DFF * DM; dst = (bf16*)(ws + WS_W_DOWN) + (size_t)idx * DM * DFF; }
            else { r -= 4 * I_DOWN;
            if (r < 4 * I_GATE) { idx = r / I_GATE; r -= idx * I_GATE; K = DM; N = DM; src = INP(33) + (size_t)idx * DM * DM; dst = (bf16*)(ws + WS_W_GATE) + (size_t)idx * DM * DM; gain = INP(5) + idx * DM; }
            else { r -= 4 * I_GATE;
            if (r < 4 * I_PROJ) { idx = r / I_PROJ; r -= idx * I_PROJ; K = PLE; N = DM; src = INP(34) + (size_t)idx * PLE * DM; dst = (bf16*)(ws + WS_W_PROJ) + (size_t)idx * DM * PLE; }
            else { r -= 4 * I_PROJ;
            if (r < 2 * I_CDIN) { idx = r / I_CDIN; r -= idx * I_CDIN; K = DM; N = ODD_IN; src = INP(20) + (size_t)idx * DM * ODD_IN; dst = (bf16*)(ws + WS_W_CDIN) + (size_t)idx * ODD_IN * DM; gain = INP(3) + (2 * idx + 1) * DM; }
            else { r -= 2 * I_CDIN;
            if (r < 2 * I_ABIN) { idx = r / I_ABIN; r -= idx * I_ABIN; K = DM; N = EVEN_IN; src = INP(7) + (size_t)idx * DM * EVEN_IN; dst = (bf16*)(ws + WS_W_ABIN) + (size_t)idx * EVEN_IN * DM; gain = INP(3) + (2 * idx) * DM; }
            else { r -= 2 * I_ABIN;
            if (r < 2 * I_ABOUT) { idx = r / I_ABOUT; r -= idx * I_ABOUT; K = EVEN_OUT; N = DM; src = INP(8) + (size_t)idx * EVEN_OUT * DM; dst = (bf16*)(ws + WS_W_ABOUT) + (size_t)idx * DM * EVEN_OUT; }
            else { r -= 2 * I_ABOUT;
            if (r < 2 * I_CDOUT) { idx = r / I_CDOUT; r -= idx * I_CDOUT; K = ODD_OUT; N = DM; src = INP(21) + (size_t)idx * ODD_OUT * DM; dst = (bf16*)(ws + WS_W_CDOUT) + (size_t)idx * DM * ODD_OUT; }
            else { r -= 2 * I_CDOUT;
            if (r < 2 * I_GLU) { idx = r / I_GLU; r -= idx * I_GLU; K = S5_W; N = S5_W; src = INP(18) + (size_t)idx * S5_W * S5_W; dst = (bf16*)(ws + WS_W_GLU) + (size_t)idx * S5_W * S5_W; }
            else { r -= 2 * I_GLU;
                idx = r / I_LRU; r -= idx * I_LRU; K = LRU_W; N = LRU_BD; src = ((idx & 1) ? INP(26) : INP(24)) + (size_t)(idx >> 1) * LRU_W * LRU_BD; dst = (bf16*)(ws + WS_W_LRU) + (size_t)idx * LRU_BD * LRU_W; }
            }}}}}}}}
            p0_transpose_item(src, K, N, dst, gain, scr, r, C.lane, up_perm);
        }
    }
    {
        const float* x = INP(0); bf16* hb = (bf16*)(ws + WS_HB0); float* ssq = (float*)(ws + WS_SSQ0);
        for (int m = C.gw; m < M; m += C.ngw) {
            const f32x4* xr = (const f32x4*)(x + (size_t)m * DM) + C.lane;
            f32x4 xv[16];
#pragma unroll
            for (int j = 0; j < 16; ++j) xv[j] = xr[64 * j];
            asm volatile("" :: "v"(xv[0]), "v"(xv[1]), "v"(xv[2]), "v"(xv[3]), "v"(xv[4]), "v"(xv[5]), "v"(xv[6]), "v"(xv[7]), "v"(xv[8]), "v"(xv[9]), "v"(xv[10]), "v"(xv[11]), "v"(xv[12]), "v"(xv[13]), "v"(xv[14]), "v"(xv[15]));
#pragma unroll
            for (int j = 0; j < 16; ++j) { const f32x4 v = xv[j];
                float s = (v[0] * v[0] + v[1] * v[1]) + (v[2] * v[2] + v[3] * v[3]);
                s += swz_xor<1>(s); s += swz_xor<2>(s); s += swz_xor<4>(s); s += swz_xor<8>(s);
                if ((C.lane & 15) == 0) ssq[(size_t)m * 64 + j * 4 + (C.lane >> 4)] = s;
                v2u o; o.x = pk2(v[0], v[1]); o.y = pk2(v[2], v[3]);
                *(v2u*)(hb + (size_t)m * DM + 256 * j + 4 * C.lane) = o; }
        }
    }
    {
        const f32x4* p4 = (const f32x4*)INP(1); v2u* o = (v2u*)(ws + WS_PB);
        for (int i = C.gt; i < DEPTH * M * PLE / 4; i += C.ngt) { const f32x4 v = p4[i]; v2u w; w.x = pk2(v[0], v[1]); w.y = pk2(v[2], v[3]); o[i] = w; }
    }
    {
        const int* pos = (const int*)INP(2); float* tab = (float*)(ws + WS_ROPE);
        for (int e = C.gt; e < M * 16; e += C.ngt) { const int row = e >> 4, i = e & 15; const float ang = (float)pos[row] * ROPE_INV[i];
            float s, c; sincos_acc(ang, s, c); tab[row * 32 + i] = c; tab[row * 32 + 16 + i] = s; }
    }
    {
        for (int e = C.gt; e < 2 * S5_NG * S5_N; e += C.ngt) { const int j = e >> 12, gn = e & 4095, g = gn >> 6;
            const float dt = expf(INP(12)[j * S5_NG + g]);
            const float lr = fminf(INP(10)[j * 4096 + gn], -1e-4f), li = INP(11)[j * 4096 + gn];
            const float mag = expf(lr * dt); float sn, cs; sincos_acc(li * dt, sn, cs);
            const float ab_re = mag * cs, ab_im = mag * sn, nr = ab_re - 1.0f, ni = ab_im, den = lr * lr + li * li;
            const float f_re = (nr * lr + ni * li) / den, f_im = (ni * lr - nr * li) / den;
            float* ta = (float*)(ws + WS_S5A) + (size_t)e * 2; ta[0] = ab_re; ta[1] = ab_im;
            float* tb = (float*)(ws + WS_S5B) + (size_t)e * 32;
            const f32x4* br = (const f32x4*)(INP(13) + (size_t)e * 16); const f32x4* bi = (const f32x4*)(INP(14) + (size_t)e * 16);
            f32x4 vr[4], vi[4];
#pragma unroll
            for (int q = 0; q < 4; ++q) { vr[q] = br[q]; vi[q] = bi[q]; }
#pragma unroll
            for (int q = 0; q < 4; ++q) { *(f32x4*)(tb + 4 * q) = f_re * vr[q] - f_im * vi[q]; *(f32x4*)(tb + 16 + 4 * q) = f_re * vi[q] + f_im * vr[q]; }
        }
    }
}

__device__ __forceinline__ unsigned off_b(unsigned row, unsigned ch) { return 256u * row + 16u * (ch ^ (((row & 3) << 2) | ((row >> 2) & 3))); }
__device__ __forceinline__ void load_tile(const bf16* src, int ld, LAS unsigned char* dst, int lane) {
    v4u v[8];
#pragma unroll
    for (int i = 0; i < 8; ++i) { const int n = lane + 64 * i, row = n >> 4, ch = n & 15; v[i] = *(const v4u*)(src + (size_t)row * ld + ch * 8); }
#pragma unroll
    for (int i = 0; i < 8; ++i) { const int n = lane + 64 * i, row = n >> 4, ch = n & 15; *(LAS v4u*)(dst + off_b(row, ch)) = v[i]; }
}
__device__ __forceinline__ void load_tile2(const bf16* srcK, const bf16* srcV, int ld, LAS unsigned char* dstK, LAS unsigned char* dstV, int lane) {
    v4u vk[8], vv[8];
#pragma unroll
    for (int i = 0; i < 8; ++i) { const int n = lane + 64 * i, row = n >> 4, ch = n & 15; vk[i] = *(const v4u*)(srcK + (size_t)row * ld + ch * 8); vv[i] = *(const v4u*)(srcV + (size_t)row * ld + ch * 8); }
    asm volatile("" :: "v"(vk[0]), "v"(vk[1]), "v"(vk[2]), "v"(vk[3]), "v"(vk[4]), "v"(vk[5]), "v"(vk[6]), "v"(vk[7]), "v"(vv[0]), "v"(vv[1]), "v"(vv[2]), "v"(vv[3]), "v"(vv[4]), "v"(vv[5]), "v"(vv[6]), "v"(vv[7]));
#pragma unroll
    for (int i = 0; i < 8; ++i) { const int n = lane + 64 * i, row = n >> 4, ch = n & 15; *(LAS v4u*)(dstK + off_b(row, ch)) = vk[i]; *(LAS v4u*)(dstV + off_b(row, ch)) = vv[i]; }
}
__device__ __forceinline__ bf16x8 frag_row(const LAS unsigned char* t, int lane, int s) { return *(const LAS bf16x8*)(t + off_b(lane & 31, 2 * s + (lane >> 5))); }
__device__ __forceinline__ s16x4 frag_tr(const LAS unsigned char* t, int lane, int c, int ks, int tt) {
    const unsigned h = lane >> 5, blk = (lane >> 4) & 1, q = (lane & 15) >> 2, p = lane & 3;
    const unsigned a = off_b(16 * ks + 8 * tt + 4 * h + q, 4 * c + 2 * blk + (p >> 1)) + 8 * (p & 1);
    typedef short v4i16_t __attribute__((ext_vector_type(4)));
    return __builtin_bit_cast(s16x4, __builtin_amdgcn_ds_read_tr16_b64_v4i16((LAS v4i16_t*)(t + a)));
}
__device__ __forceinline__ int crow(int r, int hi) { return (r & 3) + 8 * (r >> 2) + 4 * hi; }
__device__ __forceinline__ void rope_frag(bf16x8& a, bf16x8& b, const float* cs) {
    const f32x4 c0 = *(const f32x4*)cs, c1 = *(const f32x4*)(cs + 4), s0 = *(const f32x4*)(cs + 16), s1 = *(const f32x4*)(cs + 20);
#pragma unroll
    for (int j = 0; j < 8; ++j) { const float x1 = bf2f(a[j]), x2 = bf2f(b[j]), c = j < 4 ? c0[j & 3] : c1[j & 3], s = j < 4 ? s0[j & 3] : s1[j & 3];
        a[j] = f2bfs(x1 * c - x2 * s); b[j] = f2bfs(x2 * c + x1 * s); }
}
__device__ __forceinline__ void pv_tile(f32x16 (&O)[4], const f32x16& P, const LAS unsigned char* vt, int lane) {
    bf16x8 pf[2];
#pragma unroll
    for (int s = 0; s < 2; ++s) { v4u w; w.x = pk2(P[8 * s + 0], P[8 * s + 1]); w.y = pk2(P[8 * s + 2], P[8 * s + 3]); w.z = pk2(P[8 * s + 4], P[8 * s + 5]); w.w = pk2(P[8 * s + 6], P[8 * s + 7]); pf[s] = __builtin_bit_cast(bf16x8, w); }
#pragma unroll
    for (int db = 0; db < 4; ++db)
#pragma unroll
        for (int s = 0; s < 2; ++s) { const s16x4 lo = frag_tr(vt, lane, db, s, 0), hi = frag_tr(vt, lane, db, s, 1);
            const bf16x8 vf = (bf16x8){lo[0], lo[1], lo[2], lo[3], hi[0], hi[1], hi[2], hi[3]};
            O[db] = __builtin_amdgcn_mfma_f32_32x32x16_bf16(vf, pf[s], O[db], 0, 0, 0); }
}
__device__ __forceinline__ void store_ot(const f32x16 (&O)[4], float scale, bf16* dst, int hi) {
#pragma unroll
    for (int db = 0; db < 4; ++db)
#pragma unroll
        for (int rr = 0; rr < 4; ++rr) { v2u w; w.x = pk2(O[db][4 * rr] * scale, O[db][4 * rr + 1] * scale); w.y = pk2(O[db][4 * rr + 2] * scale, O[db][4 * rr + 3] * scale);
            *(v2u*)(dst + 32 * db + 8 * rr + 4 * hi) = w; }
}

__device__ __forceinline__ void swa_unit(const Ctx& C, const bf16* proj, const float* rope, const float* sinks, bf16* cat, int b, int hq, int qt) {
    const int lane = C.lane, r32 = lane & 31, hi = lane >> 5, kvh = hq >> 2, t0 = qt * 32;
    const size_t rowq = (size_t)b * SEQ + t0 + r32;
    LAS unsigned char* kt = C.wl; LAS unsigned char* vt = C.wl + 8192;
    bf16x8 qf[8];
#pragma unroll
    for (int s = 0; s < 8; ++s) qf[s] = *(const bf16x8*)(proj + rowq * EVEN_IN + hq * HD + 16 * s + 8 * hi);
    rope_frag(qf[0], qf[1], rope + rowq * 32 + 8 * hi);
    const float SC = 0.08838834764831845f * 1.4426950408889634f;
    float m = sinks[hq] * 1.4426950408889634f, lpart = hi ? 0.f : 1.f;
    f32x16 O[4];
#pragma unroll
    for (int db = 0; db < 4; ++db)
#pragma unroll
        for (int r = 0; r < 16; ++r) O[db][r] = 0.f;
    const int tq = t0 + r32;
    for (int i = 0; i < 5; ++i) {
        const int kt0 = t0 - 128 + 32 * i; if (kt0 < 0) continue;
        const size_t rowk = (size_t)b * SEQ + kt0;
        load_tile2(proj + rowk * EVEN_IN + A_Q + kvh * HD, proj + rowk * EVEN_IN + A_Q + A_KV + kvh * HD, EVEN_IN, kt, vt, lane);
        bf16x8 kf[8];
#pragma unroll
        for (int s = 0; s < 8; ++s) kf[s] = frag_row(kt, lane, s);
        rope_frag(kf[0], kf[1], rope + (rowk + r32) * 32 + 8 * hi);
        f32x16 S;
#pragma unroll
        for (int r = 0; r < 16; ++r) S[r] = 0.f;
#pragma unroll
        for (int s = 0; s < 8; ++s) S = __builtin_amdgcn_mfma_f32_32x32x16_bf16(kf[s], qf[s], S, 0, 0, 0);
        float tmax = -INFINITY;
#pragma unroll
        for (int r = 0; r < 16; ++r) { const int key = kt0 + crow(r, hi); const bool valid = (key <= tq) && (tq - key < WINDOW); S[r] = valid ? S[r] * SC : -INFINITY; tmax = fmaxf(tmax, S[r]); }
        tmax = max_xor32(tmax);
        const float mnew = fmaxf(m, tmax), alpha = __builtin_amdgcn_exp2f(m - mnew); m = mnew;
        float psum = 0.f;
#pragma unroll
        for (int r = 0; r < 16; ++r) { S[r] = __builtin_amdgcn_exp2f(S[r] - mnew); psum += S[r]; }
        lpart = lpart * alpha + psum;
#pragma unroll
        for (int db = 0; db < 4; ++db)
#pragma unroll
            for (int r = 0; r < 16; ++r) O[db][r] *= alpha;
        pv_tile(O, S, vt, lane);
    }
    const float l = add_xor32(lpart);
    store_ot(O, 1.0f / l, cat + rowq * EVEN_OUT + hq * HD, hi);
}

#ifndef SB_EARLY_EXIT
#define SB_EARLY_EXIT 1
#endif
__device__ __forceinline__ void sb_unit(const Ctx& C, const bf16* proj, bf16* cat, int b, int h, int qt) {
    const int lane = C.lane, r32 = lane & 31, hi = lane >> 5, t0 = qt * 32;
    const size_t rowq = (size_t)b * SEQ + t0 + r32;
    LAS unsigned char* kt = C.wl; LAS unsigned char* vt = C.wl + 8192;
    bf16x8 qf[8];
#pragma unroll
    for (int s = 0; s < 8; ++s) qf[s] = *(const bf16x8*)(proj + rowq * ODD_IN + h * HD + 16 * s + 8 * hi);
    f32x16 O[4];
#pragma unroll
    for (int db = 0; db < 4; ++db)
#pragma unroll
        for (int r = 0; r < 16; ++r) O[db][r] = 0.f;
    const int tq = t0 + r32;
    float c = 0.f;
    for (int kti = qt; kti >= 0; --kti) {
        const int kt0 = kti * 32; const size_t rowk = (size_t)b * SEQ + kt0;
        load_tile2(proj + rowk * ODD_IN + C_W + h * HD, proj + rowk * ODD_IN + 2 * C_W + h * HD, ODD_IN, kt, vt, lane);
        f32x16 S;
#pragma unroll
        for (int r = 0; r < 16; ++r) S[r] = 0.f;
#pragma unroll
        for (int s = 0; s < 8; ++s) S = __builtin_amdgcn_mfma_f32_32x32x16_bf16(frag_row(kt, lane, s), qf[s], S, 0, 0, 0);
        float ls[16];
        const bool diag = (kti == qt);
#pragma unroll
        for (int r = 0; r < 16; ++r) { const float z = S[r] * 0.08838834764831845f; const bool strict = !diag || (kt0 + crow(r, hi) < tq);
            const float sp = fmaxf(z, 0.f) + __logf(1.0f + __expf(-fabsf(z)));
            ls[r] = strict ? -sp : 0.f;
            S[r] = strict ? z - sp : -INFINITY; }
        float G[4], PG[4];
#pragma unroll
        for (int g = 0; g < 4; ++g) { G[g] = (ls[4 * g] + ls[4 * g + 1]) + (ls[4 * g + 2] + ls[4 * g + 3]); PG[g] = other_xor32(G[g], hi); }
        const float T3 = G[3] + PG[3], T2 = G[2] + PG[2], T1 = G[1] + PG[1], T0 = G[0] + PG[0];
        float suf[4]; suf[3] = 0.f; suf[2] = T3; suf[1] = T3 + T2; suf[0] = (T3 + T2) + T1;
#pragma unroll
        for (int g = 0; g < 4; ++g) {
            const float b3 = c + suf[g] + (hi == 0 ? PG[g] : 0.f), b2 = b3 + ls[4 * g + 3], b1 = b2 + ls[4 * g + 2], b0 = b1 + ls[4 * g + 1];
            S[4 * g + 0] = __expf(S[4 * g + 0] + b0); S[4 * g + 1] = __expf(S[4 * g + 1] + b1); S[4 * g + 2] = __expf(S[4 * g + 2] + b2); S[4 * g + 3] = __expf(S[4 * g + 3] + b3); }
        pv_tile(O, S, vt, lane);
        c += suf[0] + T0;
#if SB_EARLY_EXIT
        if (__all(c < -110.0f)) break;
#endif
    }
    store_ot(O, 1.0f, cat + rowq * ODD_OUT + h * HD, hi);
}

constexpr int S5_XP = 132;
struct S5Coef { float ar, ai; bf16x8 bf[8]; };
__device__ __forceinline__ void s5_load_coef(const unsigned char* ws, int j, int g, int lane, S5Coef& K) {
    const float* ta = (const float*)(ws + WS_S5A) + ((size_t)(j * 4096 + g * 64 + lane)) * 2; K.ar = ta[0]; K.ai = ta[1];
    const int col = lane & 15, kq = lane >> 4;
    f32x4 va[8], vb[8];
#pragma unroll
    for (int nb = 0; nb < 8; ++nb) { const int np = 16 * nb + col;
        const float* src = (const float*)(ws + WS_S5B) + ((size_t)(j * 4096 + g * 64 + (np & 63))) * 32 + (np >= 64 ? 16 : 0) + 8 * (kq & 1);
        va[nb] = *(const f32x4*)src; vb[nb] = *(const f32x4*)(src + 4); }
    asm volatile("" :: "v"(va[0]), "v"(va[1]), "v"(va[2]), "v"(va[3]), "v"(va[4]), "v"(va[5]), "v"(va[6]), "v"(va[7]), "v"(vb[0]), "v"(vb[1]), "v"(vb[2]), "v"(vb[3]), "v"(vb[4]), "v"(vb[5]), "v"(vb[6]), "v"(vb[7]));
#pragma unroll
    for (int nb = 0; nb < 8; ++nb) { const f32x4 a = va[nb], b = vb[nb];
        v4u w; w.x = pk2(a[0], a[1]); w.y = pk2(a[2], a[3]); w.z = pk2(b[0], b[1]); w.w = pk2(b[2], b[3]);
        if (kq >= 2) { w.x = 0u; w.y = 0u; w.z = 0u; w.w = 0u; }
        K.bf[nb] = __builtin_bit_cast(bf16x8, w); }
}
__device__ __forceinline__ v4u s5_load_u1(const bf16* up, int tb, int lane) { const int r = lane & 15, kq = lane >> 4; return *(const v4u*)(up + (size_t)(16 * tb + r) * EVEN_IN + 8 * (kq & 1)); }
__device__ __forceinline__ void s5_xu_block(v4u uw, const S5Coef& K, LAS float* xs, int lane) {
    const int r = lane & 15, kq = lane >> 4;
    if (kq >= 2) { uw.x = 0u; uw.y = 0u; uw.z = 0u; uw.w = 0u; }
    const bf16x8 af = __builtin_bit_cast(bf16x8, uw);
    f32x4 c[8];
#pragma unroll
    for (int nb = 0; nb < 8; ++nb) { const f32x4 z = {0.f, 0.f, 0.f, 0.f}; c[nb] = __builtin_amdgcn_mfma_f32_16x16x32_bf16(af, K.bf[nb], z, 0, 0, 0); }
    asm volatile("s_nop 7\n\ts_nop 7\n\ts_nop 7\n\ts_nop 7\n\ts_nop 7" : "+v"(c[0]), "+v"(c[1]), "+v"(c[2]), "+v"(c[3]), "+v"(c[4]), "+v"(c[5]), "+v"(c[6]), "+v"(c[7]));
#pragma unroll
    for (int nb = 0; nb < 8; ++nb)
#pragma unroll
        for (int i = 0; i < 4; ++i) xs[(4 * kq + i) * S5_XP + 16 * nb + r] = c[nb][i];
    asm volatile("s_waitcnt lgkmcnt(0)" ::: "memory"); __builtin_amdgcn_sched_barrier(0);
}
__device__ __forceinline__ void s5_pass1(const Ctx& C, unsigned char* ws, int j) {
    const bf16* proj = (const bf16*)(ws + WS_PROJ);
    float* hend = (float*)(ws + WS_S5H);
    LAS float* xs = (LAS float*)C.wl;
    const int lane = C.lane;
    const int per = (BATCH * S5_NG * NCHUNK + C.ngw - 1) / C.ngw, u0 = C.gw * per;
    int gk = -1; S5Coef K;
    for (int u = u0; u < u0 + per && u < BATCH * S5_NG * NCHUNK; ++u) {
        const int c = u % NCHUNK, g = (u / NCHUNK) % S5_NG, b = u / (NCHUNK * S5_NG);
        if (g != gk) { s5_load_coef(ws, j, g, lane, K); gk = g; }
        float hr = 0.f, hi_ = 0.f;
        const bf16* up = proj + ((size_t)b * SEQ + c * CHUNK) * EVEN_IN + (A_Q + 2 * A_KV) + g * S5_P;
        v4u ucur = s5_load_u1(up, 0, lane);
#pragma unroll 1
        for (int tb = 0; tb < CHUNK / 16; ++tb) {
            const v4u unxt = s5_load_u1(up, tb < 3 ? tb + 1 : 3, lane);
            s5_xu_block(ucur, K, xs, lane);
#pragma unroll
            for (int tt = 0; tt < 16; ++tt) { const float xr = xs[tt * S5_XP + lane], xi = xs[tt * S5_XP + 64 + lane];
                const float nr = K.ar * hr - K.ai * hi_ + xr, ni = K.ar * hi_ + K.ai * hr + xi; hr = nr; hi_ = ni; }
            ucur = unxt;
        }
        f32x2w o = {hr, hi_};
        *(f32x2w*)(hend + ((size_t)((b * S5_NG + g) * NCHUNK + c) * S5_N + lane) * 2) = o;
    }
}
__device__ __forceinline__ void s5_pass2(const Ctx& C, unsigned char* ws, const float* const* in, int j) {
    const bf16* proj = (const bf16*)(ws + WS_PROJ);
    const float* hend = (const float*)(ws + WS_S5H);
    float* GF = (float*)(ws + WS_GF); bf16* GB = (bf16*)(ws + WS_GB);
    const int lane = C.lane; const float half = opaque_f(0.5f);
    LAS float* xs = (LAS float*)C.wl;
    LAS unsigned char* hs = C.wl + 16 * S5_XP * 4;
    const int per = (BATCH * S5_NG * NCHUNK + C.ngw - 1) / C.ngw, u0 = C.gw * per;
    int gk = -1; S5Coef K; bf16x8 cf[4]; float dsk = 0.f;
    const int p = lane & 15, kq = lane >> 4;
    for (int u = u0; u < u0 + per && u < BATCH * S5_NG * NCHUNK; ++u) {
        const int c = u % NCHUNK, g = (u / NCHUNK) % S5_NG, b = u / (NCHUNK * S5_NG);
        if (g != gk) { s5_load_coef(ws, j, g, lane, K); gk = g;
#pragma unroll
            for (int ks = 0; ks < 4; ++ks) { const int k0 = 32 * ks + 8 * kq; const bool im = k0 >= 64;
                const float* src = (im ? INP(16) : INP(15)) + ((size_t)((j * S5_NG + g) * S5_P + p)) * S5_N + (k0 & 63);
                const f32x4 a = *(const f32x4*)src, bq = *(const f32x4*)(src + 4); const float sg = im ? -1.f : 1.f;
                v4u w; w.x = pk2(sg * a[0], sg * a[1]); w.y = pk2(sg * a[2], sg * a[3]); w.z = pk2(sg * bq[0], sg * bq[1]); w.w = pk2(sg * bq[2], sg * bq[3]); cf[ks] = __builtin_bit_cast(bf16x8, w); }
            dsk = INP(17)[j * S5_W + g * S5_P + p]; }
        float pr = K.ar, pi = K.ai;
#pragma unroll
        for (int q = 0; q < 6; ++q) { const float nr = pr * pr - pi * pi, tq = pr * pi; pr = nr; pi = tq + tq; }
        float hr = 0.f, hi_ = 0.f;
        const float* he = hend + ((size_t)((b * S5_NG + g) * NCHUNK) * S5_N + lane) * 2;
        for (int c0 = 0; c0 < c; c0 += 8) {
            f32x2w e[8];
#pragma unroll
            for (int k = 0; k < 8; ++k) { const int cc = (c0 + k < c) ? c0 + k : c - 1; e[k] = *(const f32x2w*)(he + (size_t)cc * S5_N * 2); }
#pragma unroll
            for (int k = 0; k < 8; ++k) if (c0 + k < c) { const float nr = pr * hr - pi * hi_ + e[k].x, ni = pr * hi_ + pi * hr + e[k].y; hr = nr; hi_ = ni; }
        }
        const size_t row0 = (size_t)b * SEQ + c * CHUNK;
        const bf16* up = proj + row0 * EVEN_IN + (A_Q + 2 * A_KV) + g * S5_P;
        v4u ucur = s5_load_u1(up, 0, lane);
#pragma unroll 1
        for (int tb = 0; tb < CHUNK / 16; ++tb) {
            const v4u unxt = s5_load_u1(up, tb < 3 ? tb + 1 : 3, lane);
            s5_xu_block(ucur, K, xs, lane); ucur = unxt;
            unsigned short us[4];
#pragma unroll
            for (int i = 0; i < 4; ++i) us[i] = up[(size_t)(16 * tb + 4 * kq + i) * EVEN_IN + p];
#pragma unroll
            for (int tt = 0; tt < 16; ++tt) { const float xr = xs[tt * S5_XP + lane], xi = xs[tt * S5_XP + 64 + lane];
                const float nr = K.ar * hr - K.ai * hi_ + xr, ni = K.ar * hi_ + K.ai * hr + xi; hr = nr; hi_ = ni;
                const unsigned w = pk2(hr, hi_);
                *(LAS unsigned short*)(hs + tt * 256 + ((((lane >> 3)) ^ tt) << 4) + (lane & 7) * 2) = (unsigned short)(w & 0xffffu);
                *(LAS unsigned short*)(hs + tt * 256 + ((((lane >> 3) + 8) ^ tt) << 4) + (lane & 7) * 2) = (unsigned short)(w >> 16); }
            f32x4 y = {0.f, 0.f, 0.f, 0.f};
#pragma unroll
            for (int ks = 0; ks < 4; ++ks) { const int t = lane & 15;
                const bf16x8 af = *(const LAS bf16x8*)(hs + t * 256 + (((4 * ks + kq) ^ t) << 4));
                y = __builtin_amdgcn_mfma_f32_16x16x32_bf16(af, cf[ks], y, 0, 0, 0); }
#pragma unroll
            for (int i = 0; i < 4; ++i) { const int t = 16 * tb + 4 * kq + i;
                const float uu = bf2f((short)us[i]);
                const float gg = gelu_tanh(y[i] + dsk * uu, half);
                GF[(row0 + t) * S5_W + g * S5_P + p] = gg;
                GB[(row0 + t) * S5_W + g * S5_P + p] = (bf16)(pk2(gg, 0.f) & 0xffffu); }
        }
    }
}

__device__ __forceinline__ void lru_gates(const Ctx& C, unsigned char* ws, const float* const* in, int j) {
    const bf16* proj = (const bf16*)(ws + WS_PROJ);
    const bf16* wt = (const bf16*)(ws + WS_W_LRU) + (size_t)(2 * j) * LRU_BD * LRU_W;
    float* LG[2] = {(float*)(ws + WS_LGA), (float*)(ws + WS_LGX)};
    const float* cw = INP(22) + (size_t)j * 4 * LRU_W; const float* cb = INP(23) + (size_t)j * LRU_W;
    for (int u = C.gw; u < (M / 32) * LRU_NB; u += C.ngw) {
        int lane = C.lane; asm volatile("" : "+v"(lane));
        const int r32 = lane & 31, hi = lane >> 5;
        const int hb = u % LRU_NB, rt = u / LRU_NB;
        LAS unsigned char* xt = C.wl;
        LAS float* wl5 = (LAS float*)(C.wl + 35 * 256);
        { const int tloc0 = (rt * 32) % SEQ;
          v4u xv[9];
#pragma unroll
          for (int i = 0; i < 9; ++i) { const int n = lane + 64 * i, jr = n >> 4, chk = n & 15; const bool ok = (n < 35 * 16) && (tloc0 - 3 + jr >= 0);
              xv[i] = *(const v4u*)(proj + ((size_t)rt * 32 + (ok ? jr - 3 : 0)) * ODD_IN + 3 * C_W + hb * LRU_BD + chk * 8);
              if (!ok) { xv[i].x = 0u; xv[i].y = 0u; xv[i].z = 0u; xv[i].w = 0u; } }
          f32x4 wv[3];
#pragma unroll
          for (int i = 0; i < 3; ++i) { const int n = lane + 64 * i, tap = n >> 5, c4 = (n & 31) * 4;
              wv[i] = (n < 160) ? *(const f32x4*)((tap < 4 ? cw + tap * LRU_W : cb) + hb * LRU_BD + c4) : (f32x4){0.f, 0.f, 0.f, 0.f}; }
#pragma unroll
          for (int i = 0; i < 9; ++i) { const int n = lane + 64 * i, jr = n >> 4, chk = n & 15; if (n < 35 * 16) *(LAS v4u*)(xt + off_b(jr, chk)) = xv[i]; }
#pragma unroll
          for (int i = 0; i < 3; ++i) { const int n = lane + 64 * i; if (n < 160) *(LAS f32x4*)(wl5 + n * 4) = wv[i]; }
        }
        bf16x8 xf[8];
#pragma unroll
        for (int s = 0; s < 8; ++s) { const int ci = 16 * s + 8 * hi;
            float a[8];
            { const f32x4 b0 = *(const LAS f32x4*)(wl5 + 4 * 128 + ci), b1 = *(const LAS f32x4*)(wl5 + 4 * 128 + ci + 4); a[0] = b0[0]; a[1] = b0[1]; a[2] = b0[2]; a[3] = b0[3]; a[4] = b1[0]; a[5] = b1[1]; a[6] = b1[2]; a[7] = b1[3]; }
#pragma unroll
            for (int k = 0; k < 4; ++k) {
                const v4u x = *(const LAS v4u*)(xt + off_b(r32 + k, 2 * s + hi));
                const f32x4 w0 = *(const LAS f32x4*)(wl5 + k * 128 + ci), w1 = *(const LAS f32x4*)(wl5 + k * 128 + ci + 4);
                a[0] += w0[0] * bflo(x.x); a[1] += w0[1] * bfhi(x.x); a[2] += w0[2] * bflo(x.y); a[3] += w0[3] * bfhi(x.y);
                a[4] += w1[0] * bflo(x.z); a[5] += w1[1] * bfhi(x.z); a[6] += w1[2] * bflo(x.w); a[7] += w1[3] * bfhi(x.w); }
            v4u w; w.x = pk2(a[0], a[1]); w.y = pk2(a[2], a[3]); w.z = pk2(a[4], a[5]); w.w = pk2(a[6], a[7]); xf[s] = __builtin_bit_cast(bf16x8, w); }
        bf16x8 idf[2];
#pragma unroll
        for (int q = 0; q < 2; ++q) { const int jj = r32 - 16 * q - 8 * hi;
#pragma unroll
            for (int e8 = 0; e8 < 8; ++e8) idf[q][e8] = (short)(e8 == jj ? 0x3F80 : 0); }
        const float* bias_a = INP(25) + (size_t)j * LRU_W + hb * LRU_BD; const float* bias_x = INP(27) + (size_t)j * LRU_W + hb * LRU_BD;
        const float* lam = INP(28) + (size_t)j * LRU_W + hb * LRU_BD;
        float ba[4], bx[4], nl[4];
#pragma unroll
        for (int cbk = 0; cbk < 4; ++cbk) { ba[cbk] = bias_a[32 * cbk + r32]; bx[cbk] = bias_x[32 * cbk + r32]; nl[cbk] = -lam[32 * cbk + r32]; }
        const bf16* wbase = wt + (size_t)r32 * LRU_W + hb * LRU_BD + 8 * hi;
#pragma unroll
        for (int cbk = 0; cbk < 4; ++cbk) {
            f32x16 acc_a, acc_x, acc_c;
#pragma unroll
            for (int r = 0; r < 16; ++r) { acc_a[r] = 0.f; acc_x[r] = 0.f; acc_c[r] = 0.f; }
            bf16x8 wa[8], wx[8];
#pragma unroll
            for (int s = 0; s < 8; ++s) { const bf16* wn = wbase + (size_t)32 * cbk * LRU_W + 16 * s; wa[s] = *(const bf16x8*)wn; wx[s] = *(const bf16x8*)(wn + (size_t)LRU_BD * LRU_W); }
            asm volatile("" :: "v"(wa[0]), "v"(wa[1]), "v"(wa[2]), "v"(wa[3]), "v"(wa[4]), "v"(wa[5]), "v"(wa[6]), "v"(wa[7]), "v"(wx[0]), "v"(wx[1]), "v"(wx[2]), "v"(wx[3]), "v"(wx[4]), "v"(wx[5]), "v"(wx[6]), "v"(wx[7]));
#pragma unroll
            for (int s = 0; s < 8; ++s) {
                acc_a = __builtin_amdgcn_mfma_f32_32x32x16_bf16(xf[s], wa[s], acc_a, 0, 0, 0);
                acc_x = __builtin_amdgcn_mfma_f32_32x32x16_bf16(xf[s], wx[s], acc_x, 0, 0, 0); }
            acc_c = __builtin_amdgcn_mfma_f32_32x32x16_bf16(xf[2 * cbk], idf[0], acc_c, 0, 0, 0);
            acc_c = __builtin_amdgcn_mfma_f32_32x32x16_bf16(xf[2 * cbk + 1], idf[1], acc_c, 0, 0, 0);
            const float spl = fmaxf(nl[cbk], 0.f) + __logf(1.0f + __expf(-fabsf(nl[cbk])));
            LAS float* ta = (LAS float*)C.wl; LAS float* td = ta + 32 * 64;
#pragma unroll
            for (int r = 0; r < 16; ++r) {
                const float rg = sigmoid_f(acc_a[r] + ba[cbk]), ig = sigmoid_f(acc_x[r] + bx[cbk]);
                const float la = -8.0f * rg * spl, a = __expf(la), a2 = a * a;
                const float om_s = -la * (2.0f + la * (2.0f + la * (1.3333334f + la * 0.6666667f))), om_d = 1.0f - a2;
                const unsigned msk = (la > -0.05f) ? 0xffffffffu : 0u;
                const float om = __uint_as_float((__float_as_uint(om_s) & msk) | (__float_as_uint(om_d) & ~msk));
                ta[crow(r, hi) * 64 + 32 * (cbk & 1) + r32] = a; td[crow(r, hi) * 64 + 32 * (cbk & 1) + r32] = __builtin_amdgcn_sqrtf(om) * (ig * acc_c[r]); }
            if (cbk & 1) {
                float* oa = LG[0] + (size_t)rt * 32 * LRU_W + hb * LRU_BD + 64 * (cbk >> 1); float* od = LG[1] + (size_t)rt * 32 * LRU_W + hb * LRU_BD + 64 * (cbk >> 1);
#pragma unroll
                for (int i = 0; i < 8; ++i) { const int row = 4 * i + (lane >> 4), c4 = (lane & 15) * 4;
                    *(f32x4*)(oa + (size_t)row * LRU_W + c4) = *(const LAS f32x4*)(ta + row * 64 + c4);
                    *(f32x4*)(od + (size_t)row * LRU_W + c4) = *(const LAS f32x4*)(td + row * 64 + c4); }
            }
        }
    }
}
template <bool FINAL> struct LruIn { f32x2w a[16], d[16]; unsigned xg[16]; };
template <bool FINAL> __device__ __forceinline__ void lru_load(LruIn<FINAL>& I, const float* pa, const float* pd, const bf16* xgp, int t0) {
#pragma unroll
    for (int k = 0; k < 16; ++k) { I.a[k] = *(const f32x2w*)(pa + (size_t)(t0 + k) * LRU_W); I.d[k] = *(const f32x2w*)(pd + (size_t)(t0 + k) * LRU_W); if (FINAL) I.xg[k] = *(const unsigned*)(xgp + (size_t)(t0 + k) * ODD_IN); }
}
template <bool FINAL> __device__ __forceinline__ void lru_scan(const Ctx& C, unsigned char* ws, const float* const* in, int j) {
    const bf16* proj = (const bf16*)(ws + WS_PROJ);
    const float* LGA = (const float*)(ws + WS_LGA); const float* LGX = (const float*)(ws + WS_LGX);
    float* SUM = (float*)(ws + WS_LSUM); bf16* cat = (bf16*)(ws + WS_CAT);
    const float half = opaque_f(0.5f);
    for (int u = C.gw; u < BATCH * NCHUNK * (LRU_W / 128); u += C.ngw) {
        const int chg = u % (LRU_W / 128), c = (u / (LRU_W / 128)) % NCHUNK, b = u / ((LRU_W / 128) * NCHUNK), ch = chg * 128 + 2 * C.lane;
        const size_t row0 = (size_t)b * SEQ + c * CHUNK;
        const bf16* xgp = proj + row0 * ODD_IN + 3 * C_W + LRU_W + ch; const float* pa = LGA + row0 * LRU_W + ch; const float* pd = LGX + row0 * LRU_W + ch;
        float h0 = 0.f, h1 = 0.f, p0 = 1.f, p1 = 1.f;
        if (FINAL) { const float* sm = SUM + ((size_t)b * NCHUNK * LRU_W + ch) * 2;
            for (int c0 = 0; c0 < c; c0 += 16) {
                f32x4 s[16];
#pragma unroll
                for (int k = 0; k < 16; ++k) { const int cc = (c0 + k < c) ? c0 + k : c - 1; s[k] = *(const f32x4*)(sm + (size_t)cc * LRU_W * 2); }
#pragma unroll
                for (int k = 0; k < 16; ++k) if (c0 + k < c) { h0 = s[k][0] * h0 + s[k][1]; h1 = s[k][2] * h1 + s[k][3]; }
            } }
        bf16* op = cat + row0 * ODD_OUT + C_W + ch;
#pragma unroll 1
        for (int t0 = 0; t0 < CHUNK; t0 += 16) {
            LruIn<FINAL> I; lru_load<FINAL>(I, pa, pd, xgp, t0);
            unsigned o_[16];
#pragma unroll
            for (int k = 0; k < 16; ++k) { h0 = I.a[k].x * h0 + I.d[k].x; h1 = I.a[k].y * h1 + I.d[k].y; p0 *= I.a[k].x; p1 *= I.a[k].y;
                if (FINAL) o_[k] = pk2(h0 * gelu_tanh(bflo(I.xg[k]), half), h1 * gelu_tanh(bfhi(I.xg[k]), half)); }
            if (FINAL) {
#pragma unroll
                for (int k = 0; k < 16; ++k) *(unsigned*)(op + (size_t)(t0 + k) * ODD_OUT) = o_[k]; }
        }
        if (!FINAL) { f32x4 s = {p0, h0, p1, h1}; *(f32x4*)(SUM + ((size_t)(b * NCHUNK + c) * LRU_W + ch) * 2) = s; }
    }
}

__device__ __forceinline__ void ffn_fixup(const Ctx& C, unsigned char* ws, const float* const* in, int layer) {
    const float* halo = (const float*)(ws + WS_HALO); bf16* act = (bf16*)(ws + WS_ACT);
    const float* cw = INP(30) + (size_t)layer * 3 * 2 * DFF; const float* cb = INP(31) + (size_t)layer * 2 * DFF;
    for (int e = C.gt; e < (M / 64) * 2 * (DFF / 4); e += C.ngt) {
        const int ch = (e % (DFF / 4)) * 4, jr = (e / (DFF / 4)) & 1, blk = e / (2 * (DFF / 4));
        const bool has_prev = ((blk * 64) % SEQ) != 0;
        f32x4 v[2][3];
#pragma unroll
        for (int gu = 0; gu < 2; ++gu) {
            const f32x4 z = {0.f, 0.f, 0.f, 0.f};
            const f32x4 cur0 = *(const f32x4*)(halo + ((size_t)(blk * 4 + 0) * 2 + gu) * DFF + ch);
            f32x4 p3 = z, p2 = z;
            if (has_prev) { p3 = *(const f32x4*)(halo + ((size_t)((blk - 1) * 4 + 3) * 2 + gu) * DFF + ch); p2 = *(const f32x4*)(halo + ((size_t)((blk - 1) * 4 + 2) * 2 + gu) * DFF + ch); }
            if (jr == 0) { v[gu][0] = p2; v[gu][1] = p3; v[gu][2] = cur0; }
            else { v[gu][0] = p3; v[gu][1] = cur0; v[gu][2] = *(const f32x4*)(halo + ((size_t)(blk * 4 + 1) * 2 + gu) * DFF + ch); }
        }
        f32x4 o;
        const f32x4 wg0 = *(const f32x4*)(cw + ch), wg1 = *(const f32x4*)(cw + 2 * DFF + ch), wg2 = *(const f32x4*)(cw + 4 * DFF + ch), bg = *(const f32x4*)(cb + ch);
        const f32x4 wu0 = *(const f32x4*)(cw + DFF + ch), wu1 = *(const f32x4*)(cw + 3 * DFF + ch), wu2 = *(const f32x4*)(cw + 5 * DFF + ch), bu = *(const f32x4*)(cb + DFF + ch);
#pragma unroll
        for (int q = 0; q < 4; ++q) { const float gc = bg[q] + wg0[q] * v[0][0][q] + wg1[q] * v[0][1][q] + wg2[q] * v[0][2][q], uc = bu[q] + wu0[q] * v[1][0][q] + wu1[q] * v[1][1][q] + wu2[q] * v[1][2][q];
            o[q] = gc * sigmoid_f(gc) * uc; }
        v2u w; w.x = pk2(o[0], o[1]); w.y = pk2(o[2], o[3]);
        *(v2u*)(act + (size_t)(blk * 64 + jr) * DFF + ch) = w;
    }
}

__device__ __forceinline__ void final_norm(const Ctx& C, const bf16* hb, const float* ssq, const float* gain, float* out) {
    f32x4 gv[16];
#pragma unroll
    for (int jj = 0; jj < 16; ++jj) gv[jj] = ((const f32x4*)gain + C.lane)[64 * jj];
    for (int m = C.gw; m < M; m += C.ngw) {
        float s = ssq[(size_t)m * 64 + C.lane];
        s += swz_xor<1>(s); s += swz_xor<2>(s); s += swz_xor<4>(s); s += swz_xor<8>(s); s += swz_xor<16>(s); s = add_xor32(s);
        const float rs = rsqrtf(s * (1.0f / DM) + 1e-6f);
        const v2u* hr = (const v2u*)(hb + (size_t)m * DM) + C.lane; f32x4* o4 = (f32x4*)(out + (size_t)m * DM) + C.lane;
        v2u hv[16];
#pragma unroll
        for (int jj = 0; jj < 16; ++jj) hv[jj] = hr[64 * jj];
        asm volatile("" :: "v"(hv[0]), "v"(hv[1]), "v"(hv[2]), "v"(hv[3]), "v"(hv[4]), "v"(hv[5]), "v"(hv[6]), "v"(hv[7]), "v"(hv[8]), "v"(hv[9]), "v"(hv[10]), "v"(hv[11]), "v"(hv[12]), "v"(hv[13]), "v"(hv[14]), "v"(hv[15]));
#pragma unroll
        for (int jj = 0; jj < 16; ++jj) { f32x4 v; v[0] = bflo(hv[jj].x); v[1] = bfhi(hv[jj].x); v[2] = bflo(hv[jj].y); v[3] = bfhi(hv[jj].y); o4[64 * jj] = v * rs * gv[jj]; }
    }
}

struct Args { const float* in[35]; float* out; unsigned char* ws; int ph_lo, ph_hi, sub, pad; };
static_assert(sizeof(Args) == 35 * 8 + 8 + 8 + 16, "Args has no padding");

__global__ void __launch_bounds__(NTHREADS, 2) hybrid_fwd(Args args) {
    extern __shared__ __attribute__((aligned(16))) unsigned char lds_raw[];
    LAS unsigned char* const lds_base = (LAS unsigned char*)lds_raw;
    const int G = gridDim.x;
    const int wave_id = __builtin_amdgcn_readfirstlane((int)threadIdx.x >> 6);
    unsigned char* const ws_arg = args.ws;
#define ENV unsigned char* ws = launder_u8(ws_arg); const float* const* in = (const float* const*)launder_u8((unsigned char*)__builtin_amdgcn_kernarg_segment_ptr()); (void)in; (void)ws; \
    const Ctx C = make_ctx(lds_base, wave_id); (void)C
#define MISC ((volatile LAS unsigned*)(lds_base + MISC_OFF))
    for (int u = threadIdx.x; u < (LDS_BYTES - MISC_OFF) / 4; u += NTHREADS) ((LAS unsigned*)(lds_base + MISC_OFF))[u] = 0u;
    __syncthreads();
    const int lo = args.ph_lo, hi = args.ph_hi, sub = args.sub;
    const bool one_launch = (hi - lo) > 1;
    if (one_launch) (void)xcd_barrier_post((unsigned*)(ws_arg + WS_CTL) + CW_BAR, MISC + 8);
#ifndef PH_MASK
#define PH_MASK 0xffffffffu
#endif
#define PH_ON(k) ((k) == 0 ? ((PH_MASK >> 15) & 1u) : (k) == 65 ? ((PH_MASK >> 31) & 1u) : ((PH_MASK >> ((((k) - 1) & 15) + ((((k) - 1) >> 4) & 1) * 16)) & 1u))
#define IN(k) (PH_ON(k) && lo <= (k) && (k) < hi)
#define SEAM(k) do { if (hi > (k) + 1) { XcdBarrier bar_; bar_.bar = (unsigned*)(launder_u8(ws_arg) + WS_CTL) + CW_BAR; bar_.x = xb_xcc_id(); bar_.st = MISC + 8; xcd_barrier(bar_); } } while (0)
    LAS unsigned char* const ring = lds_base + RING_OFF;

    if (IN(0)) { ENV; p0_prologue(C, in, ws); SEAM(0); }

    int cur = 0;
    int hcur = 0;
#define HBP(i)  ((bf16*)(ws + WS_HB0 + (size_t)(i) * (WS_HB1 - WS_HB0)))
#define SSQP(i) ((float*)(ws + WS_SSQ0 + (size_t)(i) * (WS_SSQ1 - WS_SSQ0)))
#define HP(i)   ((float*)(ws + WS_H0 + (size_t)(i) * (WS_H1 - WS_H0)))
#define PROJ ((bf16*)(ws + WS_PROJ))
#define CAT  ((bf16*)(ws + WS_CAT))

#pragma unroll 1
    for (int layer = 0; layer < DEPTH; ++layer) {
        const int pb = 1 + 16 * layer, j = layer >> 1;
        if ((layer & 1) == 0) {
            if (IN(pb + 0)) { ENV;
                pg8::Gemm g{HBP(cur), (const bf16*)(ws + WS_W_ABIN) + (size_t)j * EVEN_IN * DM, M, EVEN_IN, DM}; pg8::StaticOrder S; S.init(M, EVEN_IN, G, (int)blockIdx.x);
                pg8::EpiRowScale<true> E{PROJ, EVEN_IN, SSQP(cur), (pg8::lds_f32*)(lds_base + RING_BYTES)};
                pg8::gemm_phase<pg8::EpiRowScale<true>, pg8::StaticOrder, true, true>(ring, g, S, E, C.tid);
                SEAM(pb + 0);
            }
            if (IN(pb + 1)) { ENV;
                s5_pass1(C, ws, j);
                SEAM(pb + 1);
            }
            if (IN(pb + 2)) { ENV; s5_pass2(C, ws, in, j); SEAM(pb + 2); }
            if (IN(pb + 3)) { ENV;
                pg8::Gemm g{(const bf16*)(ws + WS_GB), (const bf16*)(ws + WS_W_GLU) + (size_t)j * S5_W * S5_W, M, S5_W, S5_W}; pg8::StaticOrder S; S.init(M, S5_W, G, (int)blockIdx.x);
                pg8::EpiGlu E{(const float*)(ws + WS_GF), INP(19) + j * S5_W, CAT, EVEN_OUT, A_Q};
                pg8::gemm_phase<pg8::EpiGlu, pg8::StaticOrder, true, true>(ring, g, S, E, C.tid);
                if (sub != 1) { const float* rope = (const float*)(ws + WS_ROPE); const float* sinks = INP(9) + j * A_HEADS;
                    unsigned* cnt = (unsigned*)(ws + WS_CTL) + CW_SWA + 64 * j;
                    for (;;) { unsigned u = 0; if (C.lane == 0) u = __hip_atomic_fetch_add(cnt, 1u, __ATOMIC_RELAXED, __HIP_MEMORY_SCOPE_AGENT); u = __builtin_amdgcn_readfirstlane(u);
                        if (u >= (unsigned)(BATCH * A_HEADS * (SEQ / 32))) break;
                        const int qt = u % (SEQ / 32), hq = (u / (SEQ / 32)) % A_HEADS, b = u / ((SEQ / 32) * A_HEADS);
                        swa_unit(C, PROJ, rope, sinks, CAT, b, hq, qt); } }
                SEAM(pb + 3);
            }
            if (IN(pb + 4)) { ENV;
                pg8::Gemm g{CAT, (const bf16*)(ws + WS_W_ABOUT) + (size_t)j * DM * EVEN_OUT, M, DM, EVEN_OUT}; pg8::StaticOrder S; S.init(M, DM, G, (int)blockIdx.x);
                pg8::EpiResidual E{HBP(cur), HBP(cur ^ 1), SSQP(cur ^ 1)};
                pg8::gemm_phase<pg8::EpiResidual, pg8::StaticOrder, true, true>(ring, g, S, E, C.tid);
                SEAM(pb + 4);
            }
        } else {
            if (IN(pb + 0)) { ENV;
                pg8::Gemm g{HBP(cur), (const bf16*)(ws + WS_W_CDIN) + (size_t)j * ODD_IN * DM, M, ODD_IN, DM}; pg8::StaticOrder S; S.init(M, ODD_IN, G, (int)blockIdx.x);
                pg8::EpiRowScale<true> E{PROJ, ODD_IN, SSQP(cur), (pg8::lds_f32*)(lds_base + RING_BYTES)};
                pg8::gemm_phase<pg8::EpiRowScale<true>, pg8::StaticOrder, true, true>(ring, g, S, E, C.tid);
                SEAM(pb + 0);
            }
            if (IN(pb + 1)) { ENV;
                if (sub != 2) for (int u = C.gw; u < BATCH * C_HEADS * (SEQ / 64); u += C.ngw) { const int q0 = u % (SEQ / 64), bh = u / (SEQ / 64), b = bh / C_HEADS, h = bh % C_HEADS;
                    sb_unit(C, PROJ, CAT, b, h, q0); sb_unit(C, PROJ, CAT, b, h, SEQ / 32 - 1 - q0); }
                if (sub != 1) lru_gates(C, ws, in, j);
                SEAM(pb + 1);
            }
            if (IN(pb + 2)) { ENV; lru_scan<false>(C, ws, in, j); SEAM(pb + 2); }
            if (IN(pb + 3)) { ENV; lru_scan<true>(C, ws, in, j); SEAM(pb + 3); }
            if (IN(pb + 4)) { ENV;
                pg8::Gemm g{CAT, (const bf16*)(ws + WS_W_CDOUT) + (size_t)j * DM * ODD_OUT, M, DM, ODD_OUT}; pg8::StaticOrder S; S.init(M, DM, G, (int)blockIdx.x);
                pg8::EpiResidual E{HBP(cur), HBP(cur ^ 1), SSQP(cur ^ 1)};
                pg8::gemm_phase<pg8::EpiResidual, pg8::StaticOrder, true, true>(ring, g, S, E, C.tid);
                SEAM(pb + 4);
            }
        }
        cur ^= 1;
        if (IN(pb + 5)) { ENV;
            { pg8::Gemm g{HBP(cur), (const bf16*)(ws + WS_W_UP) + (size_t)layer * 2 * DFF * DM, M, 2 * DFF, DM}; pg8::StaticOrder S; S.init(M, 2 * DFF, G, (int)blockIdx.x);
              pg8::EpiUpConv E{(bf16*)(ws + WS_ACT), SSQP(cur), INP(30) + (size_t)layer * 3 * 2 * DFF, INP(31) + (size_t)layer * 2 * DFF, (float*)(ws + WS_HALO), (pg8::lds_f32*)(lds_base + RING_BYTES)};
              pg8::gemm_phase<pg8::EpiUpConv, pg8::StaticOrder, true, true>(ring, g, S, E, C.tid); }
            { ENV; pg8::Gemm g{(const bf16*)(ws + WS_PB) + (size_t)layer * M * PLE, (const bf16*)(ws + WS_W_PROJ) + (size_t)layer * DM * PLE, M, DM, PLE}; pg8::StaticOrder S; S.init(M, DM, G, (int)blockIdx.x);
              pg8::EpiRowScale<false> E{(bf16*)(ws + WS_PE), DM, nullptr, nullptr};
              pg8::gemm_phase<pg8::EpiRowScale<false>, pg8::StaticOrder, true, true>(ring, g, S, E, C.tid); }
            SEAM(pb + 5);
        }
        if (IN(pb + 6)) { ENV; ffn_fixup(C, ws, in, layer); SEAM(pb + 6); }
        if (IN(pb + 7)) { ENV;
            pg8::Gemm g{(const bf16*)(ws + WS_ACT), (const bf16*)(ws + WS_W_DOWN) + (size_t)layer * DM * DFF, M, DM, DFF}; pg8::StaticOrder S; S.init(M, DM, G, (int)blockIdx.x);
            pg8::EpiResidual E{HBP(cur), HBP(cur ^ 1), SSQP(cur ^ 1)};
            pg8::gemm_phase<pg8::EpiResidual, pg8::StaticOrder, true, true>(ring, g, S, E, C.tid);
            SEAM(pb + 7);
        }
        cur ^= 1;
        if (IN(pb + 8)) { ENV;
            pg8::Gemm g{HBP(cur), (const bf16*)(ws + WS_W_GATE) + (size_t)layer * DM * DM, M, DM, DM}; pg8::StaticOrder S; S.init(M, DM, G, (int)blockIdx.x);
            pg8::EpiGate E{HBP(cur), HBP(cur ^ 1), SSQP(cur), SSQP(cur ^ 1), (const bf16*)(ws + WS_PE), (pg8::lds_f32*)(lds_base + RING_BYTES)};
            pg8::gemm_phase<pg8::EpiGate, pg8::StaticOrder, true, true>(ring, g, S, E, C.tid);
            SEAM(pb + 8);
        }
        cur ^= 1; hcur ^= 1;
    }
    if (IN(65)) { ENV; final_norm(C, HBP(cur), SSQP(cur), INP(6), args.out); }
#undef IN
#undef SEAM
}

#ifndef MK_PER_PHASE
#define MK_PER_PHASE 0
#endif
extern "C" void kernel_launch(void* const* d_in, const int* in_sizes, int n_in, void* d_out, int out_size, void* d_ws, size_t ws_size, hipStream_t stream) {
    static int grid = 0;
    if (grid == 0) {
        if (n_in != 35 || in_sizes[0] != M * DM || out_size != M * DM || ws_size < WS_END) {
            fprintf(stderr, "kernel_launch: built for 35 inputs, x/out of %d floats, >= %zu bytes of workspace; got n_in %d, in0 %d, out %d, ws %zu; nothing launched\n", M * DM, (size_t)WS_END, n_in, n_in > 0 ? in_sizes[0] : -1, out_size, ws_size);
            grid = -1; return; }
        int dev = 0, cus = 0, per_cu = 0;
        if (hipGetDevice(&dev) != hipSuccess || hipDeviceGetAttribute(&cus, hipDeviceAttributeMultiprocessorCount, dev) != hipSuccess) { fprintf(stderr, "kernel_launch: device query failed\n"); grid = -1; return; }
        if (hipFuncSetAttribute((const void*)hybrid_fwd, hipFuncAttributeMaxDynamicSharedMemorySize, LDS_BYTES) != hipSuccess) { fprintf(stderr, "kernel_launch: hipFuncSetAttribute failed\n"); grid = -1; return; }
        if (hipOccupancyMaxActiveBlocksPerMultiprocessor(&per_cu, (const void*)hybrid_fwd, NTHREADS, LDS_BYTES) != hipSuccess || per_cu < 1)
            fprintf(stderr, "kernel_launch: note: occupancy query reports %d workgroups per CU\n", per_cu);
        (void)hipGetLastError();
        grid = cus;
    }
    if (grid < 0) return;
    if (hipMemsetAsync((char*)d_ws + WS_CTL, 0, CTL_ZERO_BYTES, stream) != hipSuccess) { fprintf(stderr, "kernel_launch: memset failed\n"); return; }
    Args a{};
    for (int i = 0; i < 35; ++i) a.in[i] = (const float*)d_in[i];
    a.out = (float*)d_out; a.ws = (unsigned char*)d_ws;
#if MK_PER_PHASE
    for (int ph = 0; ph <= 65; ++ph) {
        const int k = (ph - 1) & 15;
        if (ph != 0 && ph != 65 && k > 8) continue;
        a.ph_lo = ph; a.ph_hi = ph + 1;
        hipLaunchKernelGGL(hybrid_fwd, dim3(grid), dim3(NTHREADS), LDS_BYTES, stream, a);
#if defined(PROBE_PHASE)
#ifndef PROBE_SUB
#define PROBE_SUB 0
#endif
        if (ph == PROBE_PHASE) { a.sub = PROBE_SUB; for (int r = 0; r < PROBE_REPS; ++r) hipLaunchKernelGGL(hybrid_fwd, dim3(grid), dim3(NTHREADS), LDS_BYTES, stream, a); a.sub = 0; }
#endif
    }
#else
    a.ph_lo = 0; a.ph_hi = 66;
    hipLaunchKernelGGL(hybrid_fwd, dim3(grid), dim3(NTHREADS), LDS_BYTES, stream, a);
#endif
    const hipError_t le = hipPeekAtLastError();
    if (le != hipSuccess) fprintf(stderr, "kernel_launch: launch failed: %s\n", hipGetErrorName(le));
}
```

```cpp
#include <hip/hip_runtime.h>
#include <cstdio>
#include <cstdint>
#include <cstddef>
namespace pg8 {
#define PG8_LAS __attribute__((address_space(3)))
typedef unsigned short bf16_t;
typedef short bf16x8 __attribute__((ext_vector_type(8)));
typedef float f32x4 __attribute__((ext_vector_type(4)));
typedef unsigned u32x4 __attribute__((ext_vector_type(4)));
constexpr int BM = 256, BK = 64, HALF = 128, HTB = HALF * BK * 2  , STAGE_BYTES = 8 * HTB, NXCD = 8, WGM = 8;

__host__ __device__ __forceinline__ int lds_byte(int r, int c) { const int st = (r >> 4) * 2 + (c >> 5), rr = r & 15, cc = c & 31, ob = rr * 64 + cc * 2; return st * 1024 + (ob ^ (((ob >> 9) & 1) << 5)); }
__host__ __device__ __forceinline__ void stage_rc(int b, int& R, int& C) { const int st = b / 1024, sb = b % 1024, swz = sb ^ (((sb >> 9) & 1) << 5); R = (st >> 1) * 16 + swz / 64; C = (st & 1) * 32 + (swz % 64) / 2; }
__host__ __device__ __forceinline__ int perm32(int rho) { const int n = rho >> 4, i = rho & 15; return 8 * (i >> 2) + 4 * n + (i & 3); }

struct Unit { int pm, pn; };
struct Gemm { const bf16_t* A; const bf16_t* Bt; int M, N, K; };

struct StaticOrder {
    int nM, nN, nwg, G, c;
    __host__ __device__ void init(int M, int N, int G_, int c_) { nM = M / BM; nN = N / BM; nwg = nM * nN; G = G_; c = c_; }
    __host__ __device__ bool next(int i, Unit& u) const {
        const long L = (long)i * G + c; if (L >= nwg) return false;
        int wgid = (int)L; { const int q = nwg / NXCD, r = nwg % NXCD, xcd = wgid % NXCD, off = wgid / NXCD; wgid = (xcd < r ? xcd * (q + 1) : r * (q + 1) + (xcd - r) * q) + off; }
        const int nig = WGM * nN, gid = wgid / nig, fm = gid * WGM, gsz = (nM - fm) < WGM ? (nM - fm) : WGM;
        u.pm = fm + ((wgid % nig) % gsz); u.pn = (wgid % nig) / gsz; return true;
    }
    __device__ __forceinline__ void a_ready(const Unit&) const {}
    __device__ __forceinline__ void done(const Unit&) const {}
};

__device__ __forceinline__ unsigned cvt_pk_bf16(float lo, float hi) { unsigned r; asm volatile("v_cvt_pk_bf16_f32 %0, %1, %2" : "=v"(r) : "v"(lo), "v"(hi)); return r; }
constexpr int MROWS = 8192;
typedef float f32x2v __attribute__((ext_vector_type(2)));
typedef __bf16 bf16x2v __attribute__((ext_vector_type(2)));
__device__ __forceinline__ unsigned pk2(float lo, float hi) { f32x2v v = {lo, hi}; bf16x2v b = __builtin_convertvector(v, bf16x2v); return __builtin_bit_cast(unsigned, b); }
__device__ __forceinline__ float bflo(unsigned w) { return __uint_as_float(w << 16); }
__device__ __forceinline__ float bfhi(unsigned w) { return __uint_as_float(w & 0xffff0000u); }
template <int MASK> __device__ __forceinline__ float swz_xor(float v) { static_assert(MASK > 0 && MASK < 32, "ds_swizzle bit mode"); return __int_as_float(__builtin_amdgcn_ds_swizzle(__float_as_int(v), (MASK << 10) | 0x1f)); }
__device__ __forceinline__ float add_xor32(float v) { const auto rr = __builtin_amdgcn_permlane32_swap(__float_as_uint(v), __float_as_uint(v), false, false); return __uint_as_float(rr[0]) + __uint_as_float(rr[1]); }
__device__ __forceinline__ float max_xor32(float v) { const auto rr = __builtin_amdgcn_permlane32_swap(__float_as_uint(v), __float_as_uint(v), false, false); return fmaxf(__uint_as_float(rr[0]), __uint_as_float(rr[1])); }
__device__ __forceinline__ float other_xor32(float v, int hi) { const auto rr = __builtin_amdgcn_permlane32_swap(__float_as_uint(v), __float_as_uint(v), false, false); return __uint_as_float(hi ? rr[0] : rr[1]); }
__device__ __forceinline__ void epi_lane(int& fr, int& fq) { unsigned z = 0u; asm volatile("" : "+s"(z)); const int l = (int)__builtin_amdgcn_mbcnt_hi(~0u, __builtin_amdgcn_mbcnt_lo(~0u, z)); fr = l & 15; fq = l >> 4; }
__device__ __forceinline__ float sigmoid_f(float x) { return __builtin_amdgcn_rcpf(1.0f + __expf(-x)); }
template <int PARTS = 2> __device__ __forceinline__ void rows_rstd(const float* ssq, int row0, int fq, float (&rs)[8]) {
#pragma unroll
    for (int h = 0; h < 2; ++h) {
        f32x4 v[4][4];
#pragma unroll
        for (int g = 0; g < 4; ++g) { const f32x4* p = (const f32x4*)(ssq + (unsigned)(row0 + h * HALF + g * 16) * 64u + (unsigned)(fq * 16));
#pragma unroll
            for (int q = 0; q < 4; ++q) v[g][q] = p[q]; }
        asm volatile("" :: "v"(v[0][0]), "v"(v[0][1]), "v"(v[0][2]), "v"(v[0][3]), "v"(v[1][0]), "v"(v[1][1]), "v"(v[1][2]), "v"(v[1][3]),
                           "v"(v[2][0]), "v"(v[2][1]), "v"(v[2][2]), "v"(v[2][3]), "v"(v[3][0]), "v"(v[3][1]), "v"(v[3][2]), "v"(v[3][3]));
#pragma unroll
        for (int g = 0; g < 4; ++g) { float t = 0.f;
#pragma unroll
            for (int q = 0; q < 4; ++q) { t += v[g][q][0]; t += v[g][q][1]; t += v[g][q][2]; t += v[g][q][3]; }
            t += swz_xor<16>(t); t = add_xor32(t); rs[h * 4 + g] = rsqrtf(t * (1.0f / 4096.0f) + 1e-6f); }
    }
}
typedef __attribute__((address_space(3))) float lds_f32;
__device__ __forceinline__ void rows_rstd_shared(const float* ssq, int rowbase, int wr, int wc, int fr, int fq, lds_f32* rl, float (&rs)[8]) {
    f32x4 v[2][4];
#pragma unroll
    for (int h = 0; h < 2; ++h) { const f32x4* p = (const f32x4*)(ssq + (unsigned)(rowbase + h * HALF + wc * 16 + fr) * 64u + (unsigned)(fq * 16));
#pragma unroll
        for (int q = 0; q < 4; ++q) v[h][q] = p[q]; }
    asm volatile("" :: "v"(v[0][0]), "v"(v[0][1]), "v"(v[0][2]), "v"(v[0][3]), "v"(v[1][0]), "v"(v[1][1]), "v"(v[1][2]), "v"(v[1][3]));
#pragma unroll
    for (int h = 0; h < 2; ++h) { float t = 0.f;
#pragma unroll
        for (int q = 0; q < 4; ++q) { t += v[h][q][0]; t += v[h][q][1]; t += v[h][q][2]; t += v[h][q][3]; }
        t += swz_xor<16>(t); t = add_xor32(t);
        if (fq == 0) rl[wr * 128 + h * 64 + wc * 16 + fr] = rsqrtf(t * (1.0f / 4096.0f) + 1e-6f); }
    asm volatile("s_waitcnt lgkmcnt(0)\n\ts_barrier" ::: "memory");
#pragma unroll
    for (int h = 0; h < 2; ++h)
#pragma unroll
        for (int g = 0; g < 4; ++g) rs[h * 4 + g] = rl[wr * 128 + h * 64 + g * 16 + fr];
}
__device__ __forceinline__ float sumsq8(const f32x4& v0, const f32x4& v1) { return (v0[0] * v0[0] + v0[1] * v0[1]) + (v0[2] * v0[2] + v0[3] * v0[3]) + (v1[0] * v1[0] + v1[1] * v1[1]) + (v1[2] * v1[2] + v1[3] * v1[3]); }
__device__ __forceinline__ u32x4 pack8(const f32x4& v0, const f32x4& v1) { u32x4 w; w.x = pk2(v0[0], v0[1]); w.y = pk2(v0[2], v0[3]); w.z = pk2(v1[0], v1[1]); w.w = pk2(v1[2], v1[3]); return w; }
template <bool SCALE> struct EpiRowScale {
    static constexpr bool PERM = true, AFTER_DRAIN = false;
    bf16_t* O; int ldc; const float* ssq; lds_f32* rl;
    __device__ __forceinline__ void operator()(const f32x4 (&acc)[2][2][4][2], const Unit& u, int wr, int wc, int fr, int fq) const {
        epi_lane(fr, fq);
        const int row0 = u.pm * BM + wr * 64 + fr, col0 = u.pn * BM + wc * 32 + 8 * fq;
        float rs[8];
        if (SCALE) rows_rstd_shared(ssq, u.pm * BM + wr * 64, wr, wc, fr, fq, rl, rs);
#pragma unroll
        for (int ai = 0; ai < 2; ++ai)
#pragma unroll
            for (int m = 0; m < 4; ++m) {
                const int row = row0 + ai * HALF + m * 16;
                const float r1 = SCALE ? rs[ai * 4 + m] : 1.0f;
                bf16_t* rowp = O + (size_t)row * ldc + col0;
#pragma unroll
                for (int bj = 0; bj < 2; ++bj) *(u32x4*)(rowp + bj * HALF) = pack8(acc[ai][bj][m][0] * r1, acc[ai][bj][m][1] * r1);
            }
    }
};
__device__ __forceinline__ f32x4 unlo4(const u32x4& w) { f32x4 v; v[0] = bflo(w.x); v[1] = bfhi(w.x); v[2] = bflo(w.y); v[3] = bfhi(w.y); return v; }
__device__ __forceinline__ f32x4 unhi4(const u32x4& w) { f32x4 v; v[0] = bflo(w.z); v[1] = bfhi(w.z); v[2] = bflo(w.w); v[3] = bfhi(w.w); return v; }
struct EpiResidual {
    static constexpr bool PERM = true, AFTER_DRAIN = false;
    const bf16_t* hin; bf16_t* hb; float* ssq_out;
    __device__ __forceinline__ void operator()(const f32x4 (&acc)[2][2][4][2], const Unit& u, int wr, int wc, int fr, int fq) const {
        epi_lane(fr, fq);
        const int row0 = u.pm * BM + wr * 64 + fr, col0 = u.pn * BM + wc * 32 + 8 * fq, part = u.pn * 4 + wc;
        u32x4 hw[2][8];
#pragma unroll
        for (int bj = 0; bj < 2; ++bj)
#pragma unroll
            for (int g = 0; g < 8; ++g) { const unsigned off = (unsigned)(row0 + (g >> 2) * HALF + (g & 3) * 16) * 4096u + (unsigned)(col0 + bj * HALF); hw[bj][g] = *(const u32x4*)(hin + off); }
        float ss[8];
#pragma unroll
        for (int g = 0; g < 8; ++g) ss[g] = 0.f;
#pragma unroll
        for (int bj = 0; bj < 2; ++bj)
#pragma unroll
            for (int g = 0; g < 8; ++g) { const unsigned off = (unsigned)(row0 + (g >> 2) * HALF + (g & 3) * 16) * 4096u + (unsigned)(col0 + bj * HALF);
                const u32x4 w = pack8(unlo4(hw[bj][g]) + acc[g >> 2][bj][g & 3][0], unhi4(hw[bj][g]) + acc[g >> 2][bj][g & 3][1]);
                *(u32x4*)(hb + off) = w;
                ss[g] += sumsq8(unlo4(w), unhi4(w)); }
#pragma unroll
        for (int g = 0; g < 8; ++g) { float t = ss[g]; t += swz_xor<16>(t); t = add_xor32(t); if (fq == 0) ssq_out[(unsigned)(row0 + (g >> 2) * HALF + (g & 3) * 16) * 64u + (unsigned)part] = t; }
    }
};
struct EpiGate {
    static constexpr bool PERM = true, AFTER_DRAIN = false;
    const bf16_t* hin; bf16_t* hb; const float* ssq_in; float* ssq_out; const bf16_t* pe; lds_f32* rl;
    __device__ __forceinline__ f32x4 gate4(const f32x4& h, const f32x4& a, float r1, unsigned w0, unsigned w1) const {
        f32x4 v; v[0] = h[0] + sigmoid_f(a[0] * r1) * bflo(w0); v[1] = h[1] + sigmoid_f(a[1] * r1) * bfhi(w0); v[2] = h[2] + sigmoid_f(a[2] * r1) * bflo(w1); v[3] = h[3] + sigmoid_f(a[3] * r1) * bfhi(w1); return v; }
    __device__ __forceinline__ void operator()(const f32x4 (&acc)[2][2][4][2], const Unit& u, int wr, int wc, int fr, int fq) const {
        epi_lane(fr, fq);
        const int row0 = u.pm * BM + wr * 64 + fr, col0 = u.pn * BM + wc * 32 + 8 * fq, part = u.pn * 4 + wc;
        float rs[8]; rows_rstd_shared(ssq_in, u.pm * BM + wr * 64, wr, wc, fr, fq, rl, rs);
        float ss[8];
#pragma unroll
        for (int g = 0; g < 8; ++g) ss[g] = 0.f;
#pragma unroll
        for (int bj = 0; bj < 2; ++bj) {
            u32x4 hw[8], pw[8];
#pragma unroll
            for (int g = 0; g < 8; ++g) { const unsigned off = (unsigned)(row0 + (g >> 2) * HALF + (g & 3) * 16) * 4096u + (unsigned)(col0 + bj * HALF); hw[g] = *(const u32x4*)(hin + off); pw[g] = *(const u32x4*)(pe + off); }
#pragma unroll
            for (int g = 0; g < 8; ++g) { const unsigned off = (unsigned)(row0 + (g >> 2) * HALF + (g & 3) * 16) * 4096u + (unsigned)(col0 + bj * HALF);
                const u32x4 w = pack8(gate4(unlo4(hw[g]), acc[g >> 2][bj][g & 3][0], rs[g], pw[g].x, pw[g].y), gate4(unhi4(hw[g]), acc[g >> 2][bj][g & 3][1], rs[g], pw[g].z, pw[g].w));
                *(u32x4*)(hb + off) = w;
                ss[g] += sumsq8(unlo4(w), unhi4(w)); }
        }
#pragma unroll
        for (int g = 0; g < 8; ++g) { float t = ss[g]; t += swz_xor<16>(t); t = add_xor32(t); if (fq == 0) ssq_out[(unsigned)(row0 + (g >> 2) * HALF + (g & 3) * 16) * 64u + (unsigned)part] = t; }
    }
};
template <int CTRL> __device__ __forceinline__ float dpp_f(float v) { return __int_as_float(__builtin_amdgcn_update_dpp(0, __float_as_int(v), CTRL, 0xf, 0xf, true)); }
struct EpiUpConv {
    static constexpr bool PERM = true, AFTER_DRAIN = false;
    bf16_t* act; const float* ssq; const float* cw; const float* cb; float* halo; lds_f32* rl;
    static constexpr int NCH = 10240;
    __device__ __forceinline__ void operator()(const f32x4 (&acc)[2][2][4][2], const Unit& u, int wr, int wc, int fr, int fq) const {
        epi_lane(fr, fq);
        const int row0 = u.pm * BM + wr * 64 + fr, ch0 = u.pn * HALF + wc * 32 + 8 * fq;
        f32x4 cwv[2][8];
#pragma unroll
        for (int nh = 0; nh < 2; ++nh) {
            const int chn = ch0 + 4 * nh;
            cwv[nh][0] = *(const f32x4*)(cw + chn); cwv[nh][1] = *(const f32x4*)(cw + 2 * NCH + chn); cwv[nh][2] = *(const f32x4*)(cw + 4 * NCH + chn); cwv[nh][3] = *(const f32x4*)(cb + chn);
            cwv[nh][4] = *(const f32x4*)(cw + NCH + chn); cwv[nh][5] = *(const f32x4*)(cw + 3 * NCH + chn); cwv[nh][6] = *(const f32x4*)(cw + 5 * NCH + chn); cwv[nh][7] = *(const f32x4*)(cb + NCH + chn);
        }
        float rs[8]; rows_rstd_shared(ssq, u.pm * BM + wr * 64, wr, wc, fr, fq, rl, rs);
        unsigned keep[8][2];
#pragma unroll
        for (int nh = 0; nh < 2; ++nh) {
            const int chn = ch0 + 4 * nh;
            const f32x4 wg0 = cwv[nh][0], wg1 = cwv[nh][1], wg2 = cwv[nh][2], bg = cwv[nh][3];
            const f32x4 wu0 = cwv[nh][4], wu1 = cwv[nh][5], wu2 = cwv[nh][6], bu = cwv[nh][7];
#pragma unroll
            for (int ai = 0; ai < 2; ++ai) {
                f32x4 pg = {0.f, 0.f, 0.f, 0.f}, pu = {0.f, 0.f, 0.f, 0.f};
#pragma unroll
                for (int m = 0; m < 4; ++m) {
                    const int row = row0 + ai * HALF + m * 16; const float r1 = rs[ai * 4 + m];
                    const f32x4 g = acc[ai][0][m][nh] * r1, uu = acc[ai][1][m][nh] * r1;
                    f32x4 o;
#pragma unroll
                    for (int q = 0; q < 4; ++q) {
                        float gc = bg[q] + wg2[q] * g[q], uc = bu[q] + wu2[q] * uu[q];
                        asm("s_nop 1\n\t"
                            "v_fmac_f32_dpp %0, %2, %6 row_shr:1 row_mask:0xf bank_mask:0xf bound_ctrl:1\n\t"
                            "v_fmac_f32_dpp %0, %3, %6 row_shl:15 row_mask:0xf bank_mask:0xf bound_ctrl:1\n\t"
                            "v_fmac_f32_dpp %0, %2, %7 row_shr:2 row_mask:0xf bank_mask:0xf bound_ctrl:1\n\t"
                            "v_fmac_f32_dpp %0, %3, %7 row_shl:14 row_mask:0xf bank_mask:0xf bound_ctrl:1\n\t"
                            "v_fmac_f32_dpp %1, %4, %8 row_shr:1 row_mask:0xf bank_mask:0xf bound_ctrl:1\n\t"
                            "v_fmac_f32_dpp %1, %5, %8 row_shl:15 row_mask:0xf bank_mask:0xf bound_ctrl:1\n\t"
                            "v_fmac_f32_dpp %1, %4, %9 row_shr:2 row_mask:0xf bank_mask:0xf bound_ctrl:1\n\t"
                            "v_fmac_f32_dpp %1, %5, %9 row_shl:14 row_mask:0xf bank_mask:0xf bound_ctrl:1"
                            : "+v"(gc), "+v"(uc) : "v"(g[q]), "v"(pg[q]), "v"(uu[q]), "v"(pu[q]), "v"(wg1[q]), "v"(wg0[q]), "v"(wu1[q]), "v"(wu0[q]));
                        o[q] = gc * sigmoid_f(gc) * uc; }
                    if (m == 0 && fr < 2) {
                        float* hp = halo + ((size_t)((row >> 6) * 4 + fr) * 2) * NCH + chn; *(f32x4*)hp = g; *(f32x4*)(hp + NCH) = uu; }
                    if (nh == 0) { keep[ai * 4 + m][0] = pk2(o[0], o[1]); keep[ai * 4 + m][1] = pk2(o[2], o[3]); }
                    else if (!(m == 0 && fr < 2)) { u32x4 w; w.x = keep[ai * 4 + m][0]; w.y = keep[ai * 4 + m][1]; w.z = pk2(o[0], o[1]); w.w = pk2(o[2], o[3]); *(u32x4*)(act + (size_t)row * NCH + ch0) = w; }
                    if (m == 3 && fr >= 14) { float* hp = halo + ((size_t)((row >> 6) * 4 + (fr - 12)) * 2) * NCH + chn; *(f32x4*)hp = g; *(f32x4*)(hp + NCH) = uu; }
                    pg = g; pu = uu;
                }
            }
        }
    }
};
struct EpiGlu {
    static constexpr bool PERM = true, AFTER_DRAIN = false;
    const float* g; const float* bias; bf16_t* O; int ldc, coff;
    __device__ __forceinline__ void operator()(const f32x4 (&acc)[2][2][4][2], const Unit& u, int wr, int wc, int fr, int fq) const {
        epi_lane(fr, fq);
        const int row0 = u.pm * BM + wr * 64 + fr, col0 = u.pn * BM + wc * 32 + 8 * fq;
        f32x4 bv[2][2];
#pragma unroll
        for (int bj = 0; bj < 2; ++bj) { bv[bj][0] = *(const f32x4*)(bias + col0 + bj * HALF); bv[bj][1] = *(const f32x4*)(bias + col0 + bj * HALF + 4); }
#pragma unroll
        for (int bj = 0; bj < 2; ++bj) {
            f32x4 g0[8], g1[8];
#pragma unroll
            for (int r = 0; r < 8; ++r) { const unsigned goff = (unsigned)(row0 + (r >> 2) * HALF + (r & 3) * 16) * 1024u + (unsigned)(col0 + bj * HALF); g0[r] = *(const f32x4*)(g + goff); g1[r] = *(const f32x4*)(g + goff + 4); }
#pragma unroll
            for (int r = 0; r < 8; ++r) { const int row = row0 + (r >> 2) * HALF + (r & 3) * 16;
                const f32x4 a0 = acc[r >> 2][bj][r & 3][0] + bv[bj][0], a1 = acc[r >> 2][bj][r & 3][1] + bv[bj][1];
                f32x4 v0, v1;
#pragma unroll
                for (int e = 0; e < 4; ++e) { v0[e] = g0[r][e] * sigmoid_f(a0[e]); v1[e] = g1[r][e] * sigmoid_f(a1[e]); }
                u32x4 w; w.x = pk2(v0[0], v0[1]); w.y = pk2(v0[2], v0[3]); w.z = pk2(v1[0], v1[1]); w.w = pk2(v1[2], v1[3]);
                *(u32x4*)(O + (size_t)row * ldc + coff + col0 + bj * HALF) = w; }
        }
    }
};
template <class Epi, class Sched, bool ALIGN_EPI = false, bool SP2 = false>
__device__ __forceinline__ void gemm_phase(PG8_LAS unsigned char* lds, const Gemm g, const Sched& S, const Epi& E, const int tid_in) {
    const int tid = tid_in, wid = __builtin_amdgcn_readfirstlane(tid >> 6), lane = tid & 63, wr = wid >> 2, wc = wid & 3, fr = lane & 15, fq = lane >> 4;
    const int K = g.K, nt = K / BK;
    unsigned voffA[2], voffB[2];
#pragma unroll
    for (int i = 0; i < 2; ++i) { int R, C; stage_rc(tid * 16 + i * 8192, R, C); const int Rb = Epi::PERM ? ((R & ~31) + perm32(R & 31)) : R;
        voffA[i] = (unsigned)(R * K + C) * 2u; voffB[i] = (unsigned)(Rb * K + C) * 2u; }
    const size_t kstep = (size_t)(BK * 2);
    const size_t hstep = (size_t)HALF * K * 2;
    const size_t tstep = 2 * hstep;
    const unsigned ldsw = (unsigned)wid * 1024u;
    const int aoff = lds_byte(wr * 64 + fr, fq * 8), boff = lds_byte(wc * 32 + fr, fq * 8);
#define PG8_SA(b, h) (((b) * 2 + (h)) * HTB)
#define PG8_SB(b, h) ((4 + (b) * 2 + (h)) * HTB)
#define PG8_STAGE(bufoff, gbase, voff) do { _Pragma("unroll") for (int _i = 0; _i < 2; ++_i) \
        __builtin_amdgcn_global_load_lds((const unsigned*)((const char*)(gbase) + (voff)[_i]), (PG8_LAS unsigned*)(lds + (bufoff) + ldsw + _i * 8192), 16, 0, 0); } while (0)
#define PG8_LDA(dst, b, h) do { _Pragma("unroll") for (int m = 0; m < 4; ++m) _Pragma("unroll") for (int k = 0; k < 2; ++k) dst[m][k] = *(const PG8_LAS bf16x8*)(lds + PG8_SA(b, h) + aoff + m * 2048 + k * 1024); } while (0)
#define PG8_LDB(dst, b, h) do { _Pragma("unroll") for (int n = 0; n < 2; ++n) _Pragma("unroll") for (int k = 0; k < 2; ++k) dst[n][k] = *(const PG8_LAS bf16x8*)(lds + PG8_SB(b, h) + boff + n * 2048 + k * 1024); } while (0)
#define PG8_MMA(ai, bj, At, Bt) do { __builtin_amdgcn_s_setprio(1); _Pragma("unroll") for (int m = 0; m < 4; ++m) _Pragma("unroll") for (int n = 0; n < 2; ++n) _Pragma("unroll") for (int k = 0; k < 2; ++k) \
        acc[ai][bj][m][n] = __builtin_amdgcn_mfma_f32_16x16x32_bf16(Bt[n][k], At[m][k], acc[ai][bj][m][n], 0, 0, 0); __builtin_amdgcn_s_setprio(0); } while (0)
#define PG8_WAIT_V(n) asm volatile("s_waitcnt vmcnt(" #n ")" ::: "memory")
#define PG8_WAIT_L(n) asm volatile("s_waitcnt lgkmcnt(" #n ")" ::: "memory")
#define PG8_BAR __builtin_amdgcn_s_barrier()
#define PG8_SCHED __builtin_amdgcn_sched_barrier(0)
    Unit cur, nxt; int ui = 0;
    if (!S.next(0, cur)) return;
    f32x4 acc[2][2][4][2];
#pragma unroll
    for (int a = 0; a < 2; ++a)
#pragma unroll
        for (int b = 0; b < 2; ++b)
#pragma unroll
            for (int m = 0; m < 4; ++m)
#pragma unroll
                for (int n = 0; n < 2; ++n) acc[a][b][m][n] = (f32x4){0.f, 0.f, 0.f, 0.f};
    bf16x8 At[4][2], B0[2][2], B1[2][2];
    const char* cA = (const char*)g.A + (size_t)cur.pm * tstep; const char* cB = (const char*)g.Bt + (size_t)cur.pn * tstep;
    S.a_ready(cur);
    if constexpr (SP2) {
        PG8_STAGE(PG8_SB(0, 0), cB, voffB); PG8_STAGE(PG8_SB(0, 1), cB + hstep, voffB); PG8_STAGE(PG8_SA(0, 0), cA, voffA); PG8_STAGE(PG8_SA(0, 1), cA + hstep, voffA);
        if (wr == 1) PG8_BAR;
        PG8_WAIT_V(2); PG8_BAR;
        PG8_STAGE(PG8_SB(1, 0), cB + kstep, voffB); PG8_STAGE(PG8_SA(1, 0), cA + kstep, voffA); PG8_STAGE(PG8_SB(1, 1), cB + hstep + kstep, voffB);
        PG8_WAIT_V(6); PG8_BAR;
    } else {
        PG8_STAGE(PG8_SB(0, 0), cB, voffB); PG8_STAGE(PG8_SA(0, 0), cA, voffA); PG8_STAGE(PG8_SB(0, 1), cB + hstep, voffB); PG8_STAGE(PG8_SA(0, 1), cA + hstep, voffA);
        if (wr == 1) PG8_BAR;
        PG8_WAIT_V(4); PG8_BAR;
        PG8_STAGE(PG8_SB(1, 0), cB + kstep, voffB); PG8_STAGE(PG8_SA(1, 0), cA + kstep, voffA); PG8_STAGE(PG8_SB(1, 1), cB + hstep + kstep, voffB);
        PG8_WAIT_V(6); PG8_BAR;
    }
    for (;;) {
        const bool has_next = S.next(ui + 1, nxt);
        const char* nA = has_next ? (const char*)g.A + (size_t)nxt.pm * tstep : cA; const char* nB = has_next ? (const char*)g.Bt + (size_t)nxt.pn * tstep : cB;
        for (int t = 0; t < nt; t += 2) {
            const bool last = (t == nt - 2);
            const char* a1 = cA + (size_t)(t + 1) * kstep;
            const char* a2 = last ? nA : cA + (size_t)(t + 2) * kstep; const char* b2 = last ? nB : cB + (size_t)(t + 2) * kstep;
            const char* a3 = a2 + kstep; const char* b3 = b2 + kstep;
            if (last && has_next) S.a_ready(nxt);
            if constexpr (SP2) {
            PG8_LDB(B0, 0, 0); PG8_LDB(B1, 0, 1); PG8_SCHED; PG8_LDA(At, 0, 0); PG8_STAGE(PG8_SA(1, 1), a1 + hstep, voffA);
            PG8_WAIT_V(8); PG8_WAIT_L(0); PG8_BAR; PG8_MMA(0, 0, At, B0); PG8_MMA(0, 1, At, B1); PG8_BAR; PG8_SCHED;
            PG8_LDA(At, 0, 1); PG8_STAGE(PG8_SB(0, 0), b2, voffB); PG8_STAGE(PG8_SB(0, 1), b2 + hstep, voffB); PG8_STAGE(PG8_SA(0, 0), a2, voffA);
            PG8_WAIT_V(8); PG8_WAIT_L(0); PG8_BAR; PG8_MMA(1, 0, At, B0); PG8_MMA(1, 1, At, B1); PG8_BAR; PG8_SCHED;
            PG8_LDB(B0, 1, 0); PG8_LDB(B1, 1, 1); PG8_SCHED; PG8_LDA(At, 1, 0); PG8_STAGE(PG8_SA(0, 1), a2 + hstep, voffA);
            PG8_WAIT_V(8); PG8_WAIT_L(0); PG8_BAR; PG8_MMA(0, 0, At, B0); PG8_MMA(0, 1, At, B1); PG8_BAR; PG8_SCHED;
            PG8_LDA(At, 1, 1); PG8_STAGE(PG8_SB(1, 0), b3, voffB); PG8_STAGE(PG8_SB(1, 1), b3 + hstep, voffB); PG8_STAGE(PG8_SA(1, 0), a3, voffA);
            PG8_WAIT_V(8); PG8_WAIT_L(0); PG8_BAR; PG8_MMA(1, 0, At, B0); PG8_MMA(1, 1, At, B1); PG8_BAR; PG8_SCHED;
            } else {
            PG8_LDB(B0, 0, 0); PG8_SCHED; PG8_LDA(At, 0, 0); PG8_STAGE(PG8_SA(1, 1), a1 + hstep, voffA);
            PG8_WAIT_L(8); PG8_BAR; PG8_WAIT_L(0); PG8_MMA(0, 0, At, B0); PG8_BAR; PG8_SCHED;
            PG8_LDB(B1, 0, 1); PG8_STAGE(PG8_SB(0, 0), b2, voffB);
            PG8_BAR; PG8_WAIT_L(0); PG8_MMA(0, 1, At, B1); PG8_BAR;
            PG8_LDA(At, 0, 1); PG8_STAGE(PG8_SA(0, 0), a2, voffA);
            PG8_BAR; PG8_WAIT_L(0); PG8_MMA(1, 0, At, B0); PG8_BAR; PG8_SCHED;
            PG8_STAGE(PG8_SB(0, 1), b2 + hstep, voffB);
            PG8_WAIT_V(6); PG8_BAR; PG8_MMA(1, 1, At, B1); PG8_BAR;
            PG8_LDB(B0, 1, 0); PG8_SCHED; PG8_LDA(At, 1, 0); PG8_STAGE(PG8_SA(0, 1), a2 + hstep, voffA);
            PG8_WAIT_L(8); PG8_BAR; PG8_WAIT_L(0); PG8_MMA(0, 0, At, B0); PG8_BAR; PG8_SCHED;
            PG8_LDB(B1, 1, 1); PG8_STAGE(PG8_SB(1, 0), b3, voffB);
            PG8_BAR; PG8_WAIT_L(0); PG8_MMA(0, 1, At, B1); PG8_BAR;
            PG8_LDA(At, 1, 1); PG8_STAGE(PG8_SA(1, 0), a3, voffA);
            PG8_BAR; PG8_WAIT_L(0); PG8_MMA(1, 0, At, B0); PG8_BAR; PG8_SCHED;
            PG8_STAGE(PG8_SB(1, 1), b3 + hstep, voffB);
            PG8_WAIT_V(6); PG8_BAR; PG8_MMA(1, 1, At, B1); PG8_BAR;
            }
        }
        if constexpr (ALIGN_EPI) { if (wr == 0) PG8_BAR; }
        if constexpr (!Epi::AFTER_DRAIN) { E(acc, cur, wr, wc, fr, fq); S.done(cur); }
        if (!has_next) break;
#pragma unroll
        for (int a = 0; a < 2; ++a)
#pragma unroll
            for (int b = 0; b < 2; ++b)
#pragma unroll
                for (int m = 0; m < 4; ++m)
#pragma unroll
                    for (int n = 0; n < 2; ++n) acc[a][b][m][n] = (f32x4){0.f, 0.f, 0.f, 0.f};
        cur = nxt; cA = nA; cB = nB; ++ui;
        if constexpr (ALIGN_EPI) { if (wr == 1) PG8_BAR; }
    }
    PG8_WAIT_V(0);
    if constexpr (!ALIGN_EPI) { if (wr == 0) PG8_BAR; }
    PG8_BAR;
    if constexpr (Epi::AFTER_DRAIN) { E.fused(acc, cur, wr, wc, fr, fq, lds, wid, lane); S.done(cur); }
#undef PG8_SA
#undef PG8_SB
#undef PG8_STAGE
#undef PG8_LDA
#undef PG8_LDB
#undef PG8_MMA
#undef PG8_WAIT_V
#undef PG8_WAIT_L
#undef PG8_BAR
#undef PG8_SCHED
}
}

constexpr int DM = 4096, BATCH = 2, SEQ = 4096, DEPTH = 4, M = BATCH * SEQ;
constexpr int HD = 128, A_HEADS = 16, A_KVH = 4, WINDOW = 128;
constexpr int A_Q = A_HEADS * HD, A_KV = A_KVH * HD, EVEN_IN = 4096, EVEN_OUT = 3072;
constexpr int S5_W = 1024, S5_P = 16, S5_NG = 64, S5_N = 64;
constexpr int C_HEADS = 16, C_W = 2048, ODD_IN = 10240, ODD_OUT = 4096;
constexpr int LRU_W = 2048, LRU_NB = 16, LRU_BD = 128;
constexpr int DFF = 10240, PLE = 256;
constexpr int NWAVES = 8, NTHREADS = NWAVES * 64;
constexpr int CHUNK = 64, NCHUNK = SEQ / CHUNK;
static_assert(M == pg8::MROWS, "rows");

constexpr size_t MiB = 1u << 20;
constexpr size_t WS_CTL = 0, CTL_ZERO_BYTES = 1 * MiB;
constexpr size_t WS_W_ABIN  = 1 * MiB;
constexpr size_t WS_W_ABOUT = WS_W_ABIN  + 2 * (size_t)EVEN_IN * DM * 2;
constexpr size_t WS_W_CDIN  = WS_W_ABOUT + 2 * (size_t)DM * EVEN_OUT * 2;
constexpr size_t WS_W_CDOUT = WS_W_CDIN  + 2 * (size_t)ODD_IN * DM * 2;
constexpr size_t WS_W_UP    = WS_W_CDOUT + 2 * (size_t)DM * ODD_OUT * 2;
constexpr size_t WS_W_DOWN  = WS_W_UP    + 4 * (size_t)(2 * DFF) * DM * 2;
constexpr size_t WS_W_GATE  = WS_W_DOWN  + 4 * (size_t)DM * DFF * 2;
constexpr size_t WS_W_PROJ  = WS_W_GATE  + 4 * (size_t)DM * DM * 2;
constexpr size_t WS_W_GLU   = WS_W_PROJ  + 4 * (size_t)DM * PLE * 2;
constexpr size_t WS_W_LRU   = WS_W_GLU   + 2 * (size_t)S5_W * S5_W * 2;
constexpr size_t WS_PB      = WS_W_LRU   + 2 * 2 * (size_t)LRU_BD * LRU_W * 2;
constexpr size_t WS_ROPE    = WS_PB      + (size_t)DEPTH * M * PLE * 2;
constexpr size_t WS_S5A     = WS_ROPE    + (size_t)M * 32 * 4;
constexpr size_t WS_S5B     = WS_S5A     + 2 * (size_t)4096 * 2 * 4;
constexpr size_t WS_H0      = WS_S5B     + 2 * (size_t)4096 * 32 * 4;
constexpr size_t WS_H1      = WS_H0      + (size_t)M * DM * 4;
constexpr size_t WS_HB0     = WS_H1      + (size_t)M * DM * 4;
constexpr size_t WS_HB1     = WS_HB0     + (size_t)M * DM * 2;
constexpr size_t WS_SSQ0    = WS_HB1     + (size_t)M * DM * 2;
constexpr size_t WS_SSQ1    = WS_SSQ0    + (size_t)64 * M * 4;
constexpr size_t WS_PROJ    = WS_SSQ1    + (size_t)64 * M * 4;
constexpr size_t WS_CAT     = WS_PROJ    + (size_t)M * ODD_IN * 2;
constexpr size_t WS_ACT     = WS_CAT     + (size_t)M * ODD_OUT * 2;
constexpr size_t WS_HALO    = WS_ACT     + (size_t)M * DFF * 2;
constexpr size_t WS_PE      = WS_HALO    + (size_t)(M / 64) * 4 * 2 * DFF * 4;
constexpr size_t WS_GF      = WS_PE      + (size_t)M * DM * 2;
constexpr size_t WS_GB      = WS_GF      + (size_t)M * S5_W * 4;
constexpr size_t WS_S5H     = WS_GB      + (size_t)M * S5_W * 2;
constexpr size_t WS_LGA     = WS_S5H     + (size_t)BATCH * S5_NG * NCHUNK * S5_N * 2 * 4;
constexpr size_t WS_LGX     = WS_LGA     + (size_t)M * LRU_W * 4;
constexpr size_t WS_LSUM    = WS_LGX     + (size_t)M * LRU_W * 4;
constexpr size_t WS_END     = WS_LSUM    + (size_t)BATCH * NCHUNK * LRU_W * 2 * 4;
static_assert(WS_W_ABIN % 256 == 0 && WS_H0 % 256 == 0 && WS_PROJ % 256 == 0 && WS_LSUM % 256 == 0, "alignment");
constexpr int CW_BAR = 4096, CW_SWA = 16384;

constexpr int RING_OFF = 0, RING_BYTES = 131072;
constexpr int MISC_OFF = 147456 - 512;
constexpr int LDS_BYTES = 147456;

#define GAS __attribute__((address_space(1)))
#define LAS __attribute__((address_space(3)))
typedef unsigned short bf16;
typedef unsigned v4u __attribute__((ext_vector_type(4)));
typedef unsigned v2u __attribute__((ext_vector_type(2)));
typedef float f32x4 __attribute__((ext_vector_type(4)));
typedef float f32x16 __attribute__((ext_vector_type(16)));
typedef short bf16x8 __attribute__((ext_vector_type(8)));
typedef short s16x4 __attribute__((ext_vector_type(4)));
typedef float f32x2w __attribute__((ext_vector_type(2)));
using pg8::pk2; using pg8::bflo; using pg8::bfhi; using pg8::sigmoid_f; using pg8::swz_xor; using pg8::add_xor32; using pg8::max_xor32; using pg8::other_xor32;
#define LDS_WAIT() asm volatile("s_waitcnt lgkmcnt(0)" ::: "memory")
__device__ __forceinline__ float bf2f(short s) { return __uint_as_float(((unsigned)(unsigned short)s) << 16); }
__device__ __forceinline__ short f2bfs(float a) { return (short)(pk2(a, 0.f) & 0xffffu); }
__device__ __forceinline__ float opaque_f(float v) { asm volatile("" : "+v"(v)); return v; }
__device__ __forceinline__ float gelu_tanh(float x, float half) {
    const float y = 0.7978845608028654f * (x + 0.044715f * x * x * x);
    const float t = 1.0f - 2.0f * __builtin_amdgcn_rcpf(__expf(2.0f * y) + 1.0f);
    return (half * x) * (1.0f + t);
}
#define XB_TMO      128
#define XB_XCNT(j)  (256  + 64 * (j))
#define XB_XSUB(j)  (1280 + 64 * (j))
#define XB_XGEN(j)  (2304 + 64 * (j))
#define XB_TOP      3328
#define XB_TOPGEN   3392
#define XCD_BAR_WORDS 3456
#define XB_SPIN_CAP (1u << 18)

__device__ __forceinline__ unsigned xb_ld(unsigned* p)              { return __hip_atomic_load(p, __ATOMIC_RELAXED, __HIP_MEMORY_SCOPE_AGENT); }
__device__ __forceinline__ unsigned xb_add(unsigned* p, unsigned v) { return __hip_atomic_fetch_add(p, v, __ATOMIC_RELAXED, __HIP_MEMORY_SCOPE_AGENT); }
__device__ __forceinline__ unsigned xb_xcc_id() { return (unsigned)__builtin_amdgcn_s_getreg((3 << 11) | 20) & 0xFu; }
#define XB_SPIN(cond, bar) do { unsigned _sp = 0; while (cond) { __builtin_amdgcn_s_sleep(1); \
    if ((++_sp & 255u) == 0u) { if (xb_ld(&(bar)[XB_TMO])) break; if (_sp > XB_SPIN_CAP) { atomicAdd(&(bar)[XB_TMO], 1u); break; } } } } while (0)

struct XcdBarrier {
    unsigned* bar; unsigned x;
    volatile LAS unsigned* st;
};

__device__ __forceinline__ XcdBarrier xcd_barrier_post(unsigned* bar, volatile LAS unsigned* st) {
    XcdBarrier b; b.bar = bar; b.x = xb_xcc_id(); b.st = st;
    if (threadIdx.x == 0) (void)xb_add(&bar[XB_XCNT(b.x)], 1u);
    return b;
}
__device__ __forceinline__ void xcd_barrier_complete(unsigned* bar, unsigned x, unsigned& nloc, unsigned& nx) {
    const unsigned G = gridDim.x * gridDim.y * gridDim.z;
    unsigned sum, cnt, mine, sp = 0u;
    for (;;) {
        sum = 0u; cnt = 0u; mine = 0u;
#pragma unroll
        for (unsigned j = 0; j < 16; ++j) { const unsigned c = xb_ld(&bar[XB_XCNT(j)]); sum += c; cnt += (c > 0u) ? 1u : 0u; mine = (j == x) ? c : mine; }
        if (sum == G) break;
        __builtin_amdgcn_s_sleep(1);
        if ((++sp & 255u) == 0u) { if (xb_ld(&bar[XB_TMO])) break; if (sp > XB_SPIN_CAP) { atomicAdd(&bar[XB_TMO], 1u); break; } }
    }
    nloc = mine > 0u ? mine : 1u; nx = cnt > 0u ? cnt : 1u;
}

__device__ __forceinline__ void xcd_barrier(const XcdBarrier& b) {
    asm volatile("s_waitcnt vmcnt(0)" ::: "memory");
    __syncthreads();
    if (threadIdx.x == 0) {
        unsigned* bar = b.bar;
        __builtin_amdgcn_s_waitcnt(0);
        unsigned nloc = b.st[0], nx = b.st[1];
        if (nloc == 0u) { xcd_barrier_complete(bar, b.x, nloc, nx); b.st[0] = nloc; b.st[1] = nx; }
        const unsigned old = xb_add(&bar[XB_XSUB(b.x)], 1u);
        const unsigned gen = old / nloc;
        if (old + 1u == (gen + 1u) * nloc) {
            __builtin_amdgcn_fence(__ATOMIC_RELEASE, "agent");
            asm volatile("s_waitcnt vmcnt(0)" ::: "memory");
            const unsigned og = xb_add(&bar[XB_TOP], 1u);
            const unsigned tg = og / nx;
            if (og + 1u == (tg + 1u) * nx) xb_add(&bar[XB_TOPGEN], 1u);
            else XB_SPIN(xb_ld(&bar[XB_TOPGEN]) == tg, bar);
            __builtin_amdgcn_fence(__ATOMIC_ACQUIRE, "agent");
            xb_add(&bar[XB_XGEN(b.x)], 1u);
            asm volatile("s_waitcnt vmcnt(0)" ::: "memory");
        } else {
            XB_SPIN(xb_ld(&bar[XB_XGEN(b.x)]) == gen, bar);
            __builtin_amdgcn_fence(__ATOMIC_ACQUIRE, "agent");
            asm volatile("s_waitcnt vmcnt(0)" ::: "memory");
        }
    }
    __syncthreads();
}


struct Ctx {
    LAS unsigned char* lds;
    LAS unsigned char* wl;
    int tid, lane, wave;
    int gw, ngw;
    int gt, ngt;
};

__device__ __forceinline__ Ctx make_ctx(LAS unsigned char* lds_base, int wave_id) {
    Ctx C; unsigned zero = 0u; asm volatile("" : "+s"(zero));
    const int lane = (int)__builtin_amdgcn_mbcnt_hi(~0u, __builtin_amdgcn_mbcnt_lo(~0u, zero));
    C.lds = lds_base; C.lane = lane; C.wave = wave_id; C.tid = wave_id * 64 + lane;
    C.wl = C.lds + RING_OFF + C.wave * 16384;
    const int G = gridDim.x;
    C.gw = blockIdx.x * NWAVES + C.wave; C.ngw = G * NWAVES; C.gt = blockIdx.x * NTHREADS + C.tid; C.ngt = G * NTHREADS;
    return C;
}
__device__ __forceinline__ unsigned char* launder_u8(unsigned char* p) { size_t z = 0; asm volatile("" : "+s"(z)); return p + z; }
#define INP(k) ((const float*)(const GAS float*)in[k])

constexpr int TP_PITCH = 66, TP_BYTES = 64 * TP_PITCH * 4;
__device__ __forceinline__ void p0_transpose_item(const float* W, int K, int N, bf16* WT, const float* gain, LAS unsigned* scr, int item, int lane, bool up_perm) {
    const int nblk = N / 64, kb = item / nblk, nb = item % nblk, k0 = 128 * kb, n0 = 64 * nb;
    const int n0d = !up_perm ? n0 : (n0 < DFF ? (n0 / 128) * 256 + (n0 % 128) : ((n0 - DFF) / 128) * 256 + 128 + ((n0 - DFF) % 128));
    const float* src = W + (size_t)k0 * N + n0 + lane;
    float g0 = 1.f, g1 = 1.f; if (gain) { g0 = gain[k0 + lane]; g1 = gain[k0 + 64 + lane]; }
#pragma unroll
    for (int bt = 0; bt < 4; ++bt) {
        float v[32];
#pragma unroll
        for (int i = 0; i < 32; ++i) v[i] = __builtin_nontemporal_load(src + (size_t)(32 * bt + i) * N);
#pragma unroll
        for (int i = 0; i < 16; ++i) { const int k = 32 * bt + 2 * i;
            const float ga = __uint_as_float(__builtin_amdgcn_readlane(__float_as_uint(k < 64 ? g0 : g1), k & 63)), gb = __uint_as_float(__builtin_amdgcn_readlane(__float_as_uint(k < 64 ? g0 : g1), (k + 1) & 63));
            scr[(16 * bt + i) * TP_PITCH + lane] = pk2(v[2 * i] * ga, v[2 * i + 1] * gb); }
    }
    LDS_WAIT(); asm volatile("" ::: "memory");
#pragma unroll
    for (int ps = 0; ps < 2; ++ps)
#pragma unroll
        for (int j = 0; j < 8; ++j) { const int n = (lane & 7) + 8 * j, c = (lane >> 3) + 8 * ps; const LAS unsigned* s = scr + (4 * c) * TP_PITCH + n;
            v4u o; o.x = s[0]; o.y = s[TP_PITCH]; o.z = s[2 * TP_PITCH]; o.w = s[3 * TP_PITCH];
            *(v4u*)(WT + (size_t)(n0d + n) * K + k0 + 8 * c) = o; }
    LDS_WAIT(); asm volatile("" ::: "memory");
}

__device__ const float ROPE_INV[16] = {
    1.000000000e+00f, 4.403665960e-01f, 1.939227432e-01f, 8.539710194e-02f, 3.760603070e-02f, 1.656044088e-02f, 7.292664610e-03f, 3.211446106e-03f,
    1.414213562e-03f, 6.227724371e-04f, 2.742481884e-04f, 1.207697351e-04f, 5.318295734e-05f, 2.341999971e-05f, 1.031338525e-05f, 4.541670478e-06f };

__device__ __forceinline__ void sincos_acc(float ang, float& s, float& c) {
    double r = (double)ang * 0.15915494309189535;
    r -= __builtin_rint(r);
    const float rf = (float)r;
    s = __builtin_amdgcn_sinf(rf); c = __builtin_amdgcn_cosf(rf);
}

__device__ __forceinline__ void p0_prologue(const Ctx& C, const float* const* in, unsigned char* ws) {
    LAS unsigned* scr = (LAS unsigned*)(C.lds + C.wave * TP_BYTES);
    {
        constexpr int I_ABIN = (DM / 128) * (EVEN_IN / 64), I_ABOUT = (EVEN_OUT / 128) * (DM / 64), I_CDIN = (DM / 128) * (ODD_IN / 64), I_CDOUT = (ODD_OUT / 128) * (DM / 64);
        constexpr int I_UP = (DM / 128) * (2 * DFF / 64), I_DOWN = (DFF / 128) * (DM / 64), I_GATE = (DM / 128) * (DM / 64), I_PROJ = (PLE / 128) * (DM / 64);
        constexpr int I_GLU = (S5_W / 128) * (S5_W / 64), I_LRU = (LRU_W / 128) * (LRU_BD / 64);
        constexpr int NITEMS = 2 * (I_ABIN + I_ABOUT + I_CDIN + I_CDOUT + I_GLU + 2 * I_LRU) + 4 * (I_UP + I_DOWN + I_GATE + I_PROJ);
        for (int it = C.gw; it < NITEMS; it += C.ngw) {
            int r = it; const float* src; bf16* dst; const float* gain = nullptr; int K, N, idx; bool up_perm = false;
            if (r < 4 * I_UP) { idx = r / I_UP; r -= idx * I_UP; K = DM; N = 2 * DFF; src = INP(29) + (size_t)idx * DM * 2 * DFF; dst = (bf16*)(ws + WS_W_UP) + (size_t)idx * 2 * DFF * DM; gain = INP(4) + idx * DM; up_perm = true; }
            else { r -= 4 * I_UP;
            if (r < 4 * I_DOWN) { idx = r / I_DOWN; r -= idx * I_DOWN; K = DFF; N = DM; src = INP(32) + (size_t)idx * DFF * DM; dst = (bf16*)(ws + WS_W_DOWN) + (size_t)idx * DM * DFF; }
            else { r -= 4 * I_DOWN;
            if (r < 4 * I_GATE) { idx = r / I_GATE; r -= idx * I_GATE; K = DM; N = DM; src = INP(33) + (size_t)idx * DM * DM; dst = (bf16*)(ws + WS_W_GATE) + (size_t)idx * DM * DM; gain = INP(5) + idx * DM; }
            else { r -= 4 * I_GATE;
            if (r < 4 * I_PROJ) { idx = r / I_PROJ; r -= idx * I_PROJ; K = PLE; N = DM; src = INP(34) + (size_t)idx * PLE * DM; dst = (bf16*)(ws + WS_W_PROJ) + (size_t)idx * DM * PLE; }
            else { r -= 4 * I_PROJ;
            if (r < 2 * I_CDIN) { idx = r / I_CDIN; r -= idx * I_CDIN; K = DM; N = ODD_IN; src = INP(20) + (size_t)idx * DM * ODD_IN; dst = (bf16*)(ws + WS_W_CDIN) + (size_t)idx * ODD_IN * DM; gain = INP(3) + (2 * idx + 1) * DM; }
            else { r -= 2 * I_CDIN;
            if (r < 2 * I_ABIN) { idx = r / I_ABIN; r -= idx * I_ABIN; K = DM; N = EVEN_IN; src = INP(7) + (size_t)idx * DM * EVEN_IN; dst = (bf16*)(ws + WS_W_ABIN) + (size_t)idx * EVEN_IN * DM; gain = INP(3) + (2 * idx) * DM; }
            else { r -= 2 * I_ABIN;
            if (r < 2 * I_ABOUT) { idx = r / I_ABOUT; r -= idx * I_ABOUT; K = EVEN_OUT; N = DM; src = INP(8) + (size_t)idx * EVEN_OUT * DM; dst = (bf16*)(ws + WS_W_ABOUT) + (size_t)idx * DM * EVEN_OUT; }
            else { r -= 2 * I_ABOUT;
            if (r < 2 * I_CDOUT) { idx = r / I_CDOUT; r -= idx * I_CDOUT; K = ODD_OUT; N = DM; src = INP(21) + (size_t)idx * ODD_OUT * DM; dst = (bf16*)(ws + WS_W_CDOUT) + (size_t)idx * DM * ODD_OUT; }
            else { r -= 2 * I_CDOUT;
            if (r < 2 * I_GLU) { idx = r / I_GLU; r -= idx * I_GLU; K = S5_W; N = S5_W; src = INP(18) + (size_t)idx * S5_W * S5_W; dst = (bf16*)(ws + WS_W_GLU) + (size_t)idx * S5_W * S5_W; }
            else { r -= 2 * I_GLU;
                idx = r / I_LRU; r -= idx * I_LRU; K = LRU_W; N = LRU_BD; src = ((idx & 1) ? INP(26) : INP(24)) + (size_t)(idx >> 1) * LRU_W * LRU_BD; dst = (bf16*)(ws + WS_W_LRU) + (size_t)idx * LRU_BD * LRU_W; }
            }}}}}}}}
            p0_transpose_item(src, K, N, dst, gain, scr, r, C.lane, up_perm);
        }
    }
    {
        const float* x = INP(0); bf16* hb = (bf16*)(ws + WS_HB0); float* ssq = (float*)(ws + WS_SSQ0);
        for (int m = C.gw; m < M; m += C.ngw) {
            const f32x4* xr = (const f32x4*)(x + (size_t)m * DM) + C.lane;
            f32x4 xv[16];
#pragma unroll
            for (int j = 0; j < 16; ++j) xv[j] = xr[64 * j];
            asm volatile("" :: "v"(xv[0]), "v"(xv[1]), "v"(xv[2]), "v"(xv[3]), "v"(xv[4]), "v"(xv[5]), "v"(xv[6]), "v"(xv[7]), "v"(xv[8]), "v"(xv[9]), "v"(xv[10]), "v"(xv[11]), "v"(xv[12]), "v"(xv[13]), "v"(xv[14]), "v"(xv[15]));
#pragma unroll
            for (int j = 0; j < 16; ++j) { const f32x4 v = xv[j];
                float s = (v[0] * v[0] + v[1] * v[1]) + (v[2] * v[2] + v[3] * v[3]);
                s += swz_xor<1>(s); s += swz_xor<2>(s); s += swz_xor<4>(s); s += swz_xor<8>(s);
                if ((C.lane & 15) == 0) ssq[(size_t)m * 64 + j * 4 + (C.lane >> 4)] = s;
                v2u o; o.x = pk2(v[0], v[1]); o.y = pk2(v[2], v[3]);
                *(v2u*)(hb + (size_t)m * DM + 256 * j + 4 * C.lane) = o; }
        }
    }
    {
        const f32x4* p4 = (const f32x4*)INP(1); v2u* o = (v2u*)(ws + WS_PB);
        for (int i = C.gt; i < DEPTH * M * PLE / 4; i += C.ngt) { const f32x4 v = p4[i]; v2u w; w.x = pk2(v[0], v[1]); w.y = pk2(v[2], v[3]); o[i] = w; }
    }
    {
        const int* pos = (const int*)INP(2); float* tab = (float*)(ws + WS_ROPE);
        for (int e = C.gt; e < M * 16; e += C.ngt) { const int row = e >> 4, i = e & 15; const float ang = (float)pos[row] * ROPE_INV[i];
            float s, c; sincos_acc(ang, s, c); tab[row * 32 + i] = c; tab[row * 32 + 16 + i] = s; }
    }
    {
        for (int e = C.gt; e < 2 * S5_NG * S5_N; e += C.ngt) { const int j = e >> 12, gn = e & 4095, g = gn >> 6;
            const float dt = expf(INP(12)[j * S5_NG + g]);
            const float lr = fminf(INP(10)[j * 4096 + gn], -1e-4f), li = INP(11)[j * 4096 + gn];
            const float mag = expf(lr * dt); float sn, cs; sincos_acc(li * dt, sn, cs);
            const float ab_re = mag * cs, ab_im = mag * sn, nr = ab_re - 1.0f, ni = ab_im, den = lr * lr + li * li;
            const float f_re = (nr * lr + ni * li) / den, f_im = (ni * lr - nr * li) / den;
            float* ta = (float*)(ws + WS_S5A) + (size_t)e * 2; ta[0] = ab_re; ta[1] = ab_im;
            float* tb = (float*)(ws + WS_S5B) + (size_t)e * 32;
            const f32x4* br = (const f32x4*)(INP(13) + (size_t)e * 16); const f32x4* bi = (const f32x4*)(INP(14) + (size_t)e * 16);
            f32x4 vr[4], vi[4];
#pragma unroll
            for (int q = 0; q < 4; ++q) { vr[q] = br[q]; vi[q] = bi[q]; }
#pragma unroll
            for (int q = 0; q < 4; ++q) { *(f32x4*)(tb + 4 * q) = f_re * vr[q] - f_im * vi[q]; *(f32x4*)(tb + 16 + 4 * q) = f_re * vi[q] + f_im * vr[q]; }
        }
    }
}

__device__ __forceinline__ unsigned off_b(unsigned row, unsigned ch) { return 256u * row + 16u * (ch ^ (((row & 3) << 2) | ((row >> 2) & 3))); }
__device__ __forceinline__ void load_tile(const bf16* src, int ld, LAS unsigned char* dst, int lane) {
    v4u v[8];
#pragma unroll
    for (int i = 0; i < 8; ++i) { const int n = lane + 64 * i, row = n >> 4, ch = n & 15; v[i] = *(const v4u*)(src + (size_t)row * ld + ch * 8); }
#pragma unroll
    for (int i = 0; i < 8; ++i) { const int n = lane + 64 * i, row = n >> 4, ch = n & 15; *(LAS v4u*)(dst + off_b(row, ch)) = v[i]; }
}
__device__ __forceinline__ void load_tile2(const bf16* srcK, const bf16* srcV, int ld, LAS unsigned char* dstK, LAS unsigned char* dstV, int lane) {
    v4u vk[8], vv[8];
#pragma unroll
    for (int i = 0; i < 8; ++i) { const int n = lane + 64 * i, row = n >> 4, ch = n & 15; vk[i] = *(const v4u*)(srcK + (size_t)row * ld + ch * 8); vv[i] = *(const v4u*)(srcV + (size_t)row * ld + ch * 8); }
    asm volatile("" :: "v"(vk[0]), "v"(vk[1]), "v"(vk[2]), "v"(vk[3]), "v"(vk[4]), "v"(vk[5]), "v"(vk[6]), "v"(vk[7]), "v"(vv[0]), "v"(vv[1]), "v"(vv[2]), "v"(vv[3]), "v"(vv[4]), "v"(vv[5]), "v"(vv[6]), "v"(vv[7]));
#pragma unroll
    for (int i = 0; i < 8; ++i) { const int n = lane + 64 * i, row = n >> 4, ch = n & 15; *(LAS v4u*)(dstK + off_b(row, ch)) = vk[i]; *(LAS v4u*)(dstV + off_b(row, ch)) = vv[i]; }
}
__device__ __forceinline__ bf16x8 frag_row(const LAS unsigned char* t, int lane, int s) { return *(const LAS bf16x8*)(t + off_b(lane & 31, 2 * s + (lane >> 5))); }
__device__ __forceinline__ s16x4 frag_tr(const LAS unsigned char* t, int lane, int c, int ks, int tt) {
    const unsigned h = lane >> 5, blk = (lane >> 4) & 1, q = (lane & 15) >> 2, p = lane & 3;
    const unsigned a = off_b(16 * ks + 8 * tt + 4 * h + q, 4 * c + 2 * blk + (p >> 1)) + 8 * (p & 1);
    typedef short v4i16_t __attribute__((ext_vector_type(4)));
    return __builtin_bit_cast(s16x4, __builtin_amdgcn_ds_read_tr16_b64_v4i16((LAS v4i16_t*)(t + a)));
}
__device__ __forceinline__ int crow(int r, int hi) { return (r & 3) + 8 * (r >> 2) + 4 * hi; }
__device__ __forceinline__ void rope_frag(bf16x8& a, bf16x8& b, const float* cs) {
    const f32x4 c0 = *(const f32x4*)cs, c1 = *(const f32x4*)(cs + 4), s0 = *(const f32x4*)(cs + 16), s1 = *(const f32x4*)(cs + 20);
#pragma unroll
    for (int j = 0; j < 8; ++j) { const float x1 = bf2f(a[j]), x2 = bf2f(b[j]), c = j < 4 ? c0[j & 3] : c1[j & 3], s = j < 4 ? s0[j & 3] : s1[j & 3];
        a[j] = f2bfs(x1 * c - x2 * s); b[j] = f2bfs(x2 * c + x1 * s); }
}
__device__ __forceinline__ void pv_tile(f32x16 (&O)[4], const f32x16& P, const LAS unsigned char* vt, int lane) {
    bf16x8 pf[2];
#pragma unroll
    for (int s = 0; s < 2; ++s) { v4u w; w.x = pk2(P[8 * s + 0], P[8 * s + 1]); w.y = pk2(P[8 * s + 2], P[8 * s + 3]); w.z = pk2(P[8 * s + 4], P[8 * s + 5]); w.w = pk2(P[8 * s + 6], P[8 * s + 7]); pf[s] = __builtin_bit_cast(bf16x8, w); }
#pragma unroll
    for (int db = 0; db < 4; ++db)
#pragma unroll
        for (int s = 0; s < 2; ++s) { const s16x4 lo = frag_tr(vt, lane, db, s, 0), hi = frag_tr(vt, lane, db, s, 1);
            const bf16x8 vf = (bf16x8){lo[0], lo[1], lo[2], lo[3], hi[0], hi[1], hi[2], hi[3]};
            O[db] = __builtin_amdgcn_mfma_f32_32x32x16_bf16(vf, pf[s], O[db], 0, 0, 0); }
}
__device__ __forceinline__ void store_ot(const f32x16 (&O)[4], float scale, bf16* dst, int hi) {
#pragma unroll
    for (int db = 0; db < 4; ++db)
#pragma unroll
        for (int rr = 0; rr < 4; ++rr) { v2u w; w.x = pk2(O[db][4 * rr] * scale, O[db][4 * rr + 1] * scale); w.y = pk2(O[db][4 * rr + 2] * scale, O[db][4 * rr + 3] * scale);
            *(v2u*)(dst + 32 * db + 8 * rr + 4 * hi) = w; }
}

__device__ __forceinline__ void swa_unit(const Ctx& C, const bf16* proj, const float* rope, const float* sinks, bf16* cat, int b, int hq, int qt) {
    const int lane = C.lane, r32 = lane & 31, hi = lane >> 5, kvh = hq >> 2, t0 = qt * 32;
    const size_t rowq = (size_t)b * SEQ + t0 + r32;
    LAS unsigned char* kt = C.wl; LAS unsigned char* vt = C.wl + 8192;
    bf16x8 qf[8];
#pragma unroll
    for (int s = 0; s < 8; ++s) qf[s] = *(const bf16x8*)(proj + rowq * EVEN_IN + hq * HD + 16 * s + 8 * hi);
    rope_frag(qf[0], qf[1], rope + rowq * 32 + 8 * hi);
    const float SC = 0.08838834764831845f * 1.4426950408889634f;
    float m = sinks[hq] * 1.4426950408889634f, lpart = hi ? 0.f : 1.f;
    f32x16 O[4];
#pragma unroll
    for (int db = 0; db < 4; ++db)
#pragma unroll
        for (int r = 0; r < 16; ++r) O[db][r] = 0.f;
    const int tq = t0 + r32;
    for (int i = 0; i < 5; ++i) {
        const int kt0 = t0 - 128 + 32 * i; if (kt0 < 0) continue;
        const size_t rowk = (size_t)b * SEQ + kt0;
        load_tile2(proj + rowk * EVEN_IN + A_Q + kvh * HD, proj + rowk * EVEN_IN + A_Q + A_KV + kvh * HD, EVEN_IN, kt, vt, lane);
        bf16x8 kf[8];
#pragma unroll
        for (int s = 0; s < 8; ++s) kf[s] = frag_row(kt, lane, s);
        rope_frag(kf[0], kf[1], rope + (rowk + r32) * 32 + 8 * hi);
        f32x16 S;
#pragma unroll
        for (int r = 0; r < 16; ++r) S[r] = 0.f;
#pragma unroll
        for (int s = 0; s < 8; ++s) S = __builtin_amdgcn_mfma_f32_32x32x16_bf16(kf[s], qf[s], S, 0, 0, 0);
        float tmax = -INFINITY;
#pragma unroll
        for (int r = 0; r < 16; ++r) { const int key = kt0 + crow(r, hi); const bool valid = (key <= tq) && (tq - key < WINDOW); S[r] = valid ? S[r] * SC : -INFINITY; tmax = fmaxf(tmax, S[r]); }
        tmax = max_xor32(tmax);
        const float mnew = fmaxf(m, tmax), alpha = __builtin_amdgcn_exp2f(m - mnew); m = mnew;
        float psum = 0.f;
#pragma unroll
        for (int r = 0; r < 16; ++r) { S[r] = __builtin_amdgcn_exp2f(S[r] - mnew); psum += S[r]; }
        lpart = lpart * alpha + psum;
#pragma unroll
        for (int db = 0; db < 4; ++db)
#pragma unroll
            for (int r = 0; r < 16; ++r) O[db][r] *= alpha;
        pv_tile(O, S, vt, lane);
    }
    const float l = add_xor32(lpart);
    store_ot(O, 1.0f / l, cat + rowq * EVEN_OUT + hq * HD, hi);
}

#ifndef SB_EARLY_EXIT
#define SB_EARLY_EXIT 1
#endif
__device__ __forceinline__ void sb_unit(const Ctx& C, const bf16* proj, bf16* cat, int b, int h, int qt) {
    const int lane = C.lane, r32 = lane & 31, hi = lane >> 5, t0 = qt * 32;
    const size_t rowq = (size_t)b * SEQ + t0 + r32;
    LAS unsigned char* kt = C.wl; LAS unsigned char* vt = C.wl + 8192;
    bf16x8 qf[8];
#pragma unroll
    for (int s = 0; s < 8; ++s) qf[s] = *(const bf16x8*)(proj + rowq * ODD_IN + h * HD + 16 * s + 8 * hi);
    f32x16 O[4];
#pragma unroll
    for (int db = 0; db < 4; ++db)
#pragma unroll
        for (int r = 0; r < 16; ++r) O[db][r] = 0.f;
    const int tq = t0 + r32;
    float c = 0.f;
    for (int kti = qt; kti >= 0; --kti) {
        const int kt0 = kti * 32; const size_t rowk = (size_t)b * SEQ + kt0;
        load_tile2(proj + rowk * ODD_IN + C_W + h * HD, proj + rowk * ODD_IN + 2 * C_W + h * HD, ODD_IN, kt, vt, lane);
        f32x16 S;
#pragma unroll
        for (int r = 0; r < 16; ++r) S[r] = 0.f;
#pragma unroll
        for (int s = 0; s < 8; ++s) S = __builtin_amdgcn_mfma_f32_32x32x16_bf16(frag_row(kt, lane, s), qf[s], S, 0, 0, 0);
        float ls[16];
        const bool diag = (kti == qt);
#pragma unroll
        for (int r = 0; r < 16; ++r) { const float z = S[r] * 0.08838834764831845f; const bool strict = !diag || (kt0 + crow(r, hi) < tq);
            const float sp = fmaxf(z, 0.f) + __logf(1.0f + __expf(-fabsf(z)));
            ls[r] = strict ? -sp : 0.f;
            S[r] = strict ? z - sp : -INFINITY; }
        float G[4], PG[4];
#pragma unroll
        for (int g = 0; g < 4; ++g) { G[g] = (ls[4 * g] + ls[4 * g + 1]) + (ls[4 * g + 2] + ls[4 * g + 3]); PG[g] = other_xor32(G[g], hi); }
        const float T3 = G[3] + PG[3], T2 = G[2] + PG[2], T1 = G[1] + PG[1], T0 = G[0] + PG[0];
        float suf[4]; suf[3] = 0.f; suf[2] = T3; suf[1] = T3 + T2; suf[0] = (T3 + T2) + T1;
#pragma unroll
        for (int g = 0; g < 4; ++g) {
            const float b3 = c + suf[g] + (hi == 0 ? PG[g] : 0.f), b2 = b3 + ls[4 * g + 3], b1 = b2 + ls[4 * g + 2], b0 = b1 + ls[4 * g + 1];
            S[4 * g + 0] = __expf(S[4 * g + 0] + b0); S[4 * g + 1] = __expf(S[4 * g + 1] + b1); S[4 * g + 2] = __expf(S[4 * g + 2] + b2); S[4 * g + 3] = __expf(S[4 * g + 3] + b3); }
        pv_tile(O, S, vt, lane);
        c += suf[0] + T0;
#if SB_EARLY_EXIT
        if (__all(c < -110.0f)) break;
#endif
    }
    store_ot(O, 1.0f, cat + rowq * ODD_OUT + h * HD, hi);
}

constexpr int S5_XP = 132;
struct S5Coef { float ar, ai; bf16x8 bf[8]; };
__device__ __forceinline__ void s5_load_coef(const unsigned char* ws, int j, int g, int lane, S5Coef& K) {
    const float* ta = (const float*)(ws + WS_S5A) + ((size_t)(j * 4096 + g * 64 + lane)) * 2; K.ar = ta[0]; K.ai = ta[1];
    const int col = lane & 15, kq = lane >> 4;
    f32x4 va[8], vb[8];
#pragma unroll
    for (int nb = 0; nb < 8; ++nb) { const int np = 16 * nb + col;
        const float* src = (const float*)(ws + WS_S5B) + ((size_t)(j * 4096 + g * 64 + (np & 63))) * 32 + (np >= 64 ? 16 : 0) + 8 * (kq & 1);
        va[nb] = *(const f32x4*)src; vb[nb] = *(const f32x4*)(src + 4); }
    asm volatile("" :: "v"(va[0]), "v"(va[1]), "v"(va[2]), "v"(va[3]), "v"(va[4]), "v"(va[5]), "v"(va[6]), "v"(va[7]), "v"(vb[0]), "v"(vb[1]), "v"(vb[2]), "v"(vb[3]), "v"(vb[4]), "v"(vb[5]), "v"(vb[6]), "v"(vb[7]));
#pragma unroll
    for (int nb = 0; nb < 8; ++nb) { const f32x4 a = va[nb], b = vb[nb];
        v4u w; w.x = pk2(a[0], a[1]); w.y = pk2(a[2], a[3]); w.z = pk2(b[0], b[1]); w.w = pk2(b[2], b[3]);
        if (kq >= 2) { w.x = 0u; w.y = 0u; w.z = 0u; w.w = 0u; }
        K.bf[nb] = __builtin_bit_cast(bf16x8, w); }
}
__device__ __forceinline__ v4u s5_load_u1(const bf16* up, int tb, int lane) { const int r = lane & 15, kq = lane >> 4; return *(const v4u*)(up + (size_t)(16 * tb + r) * EVEN_IN + 8 * (kq & 1)); }
__device__ __forceinline__ void s5_xu_block(v4u uw, const S5Coef& K, LAS float* xs, int lane) {
    const int r = lane & 15, kq = lane >> 4;
    if (kq >= 2) { uw.x = 0u; uw.y = 0u; uw.z = 0u; uw.w = 0u; }
    const bf16x8 af = __builtin_bit_cast(bf16x8, uw);
    f32x4 c[8];
#pragma unroll
    for (int nb = 0; nb < 8; ++nb) { const f32x4 z = {0.f, 0.f, 0.f, 0.f}; c[nb] = __builtin_amdgcn_mfma_f32_16x16x32_bf16(af, K.bf[nb], z, 0, 0, 0); }
    asm volatile("s_nop 7\n\ts_nop 7\n\ts_nop 7\n\ts_nop 7\n\ts_nop 7" : "+v"(c[0]), "+v"(c[1]), "+v"(c[2]), "+v"(c[3]), "+v"(c[4]), "+v"(c[5]), "+v"(c[6]), "+v"(c[7]));
#pragma unroll
    for (int nb = 0; nb < 8; ++nb)
#pragma unroll
        for (int i = 0; i < 4; ++i) xs[(4 * kq + i) * S5_XP + 16 * nb + r] = c[nb][i];
    asm volatile("s_waitcnt lgkmcnt(0)" ::: "memory"); __builtin_amdgcn_sched_barrier(0);
}
__device__ __forceinline__ void s5_pass1(const Ctx& C, unsigned char* ws, int j) {
    const bf16* proj = (const bf16*)(ws + WS_PROJ);
    float* hend = (float*)(ws + WS_S5H);
    LAS float* xs = (LAS float*)C.wl;
    const int lane = C.lane;
    const int per = (BATCH * S5_NG * NCHUNK + C.ngw - 1) / C.ngw, u0 = C.gw * per;
    int gk = -1; S5Coef K;
    for (int u = u0; u < u0 + per && u < BATCH * S5_NG * NCHUNK; ++u) {
        const int c = u % NCHUNK, g = (u / NCHUNK) % S5_NG, b = u / (NCHUNK * S5_NG);
        if (g != gk) { s5_load_coef(ws, j, g, lane, K); gk = g; }
        float hr = 0.f, hi_ = 0.f;
        const bf16* up = proj + ((size_t)b * SEQ + c * CHUNK) * EVEN_IN + (A_Q + 2 * A_KV) + g * S5_P;
        v4u ucur = s5_load_u1(up, 0, lane);
#pragma unroll 1
        for (int tb = 0; tb < CHUNK / 16; ++tb) {
            const v4u unxt = s5_load_u1(up, tb < 3 ? tb + 1 : 3, lane);
            s5_xu_block(ucur, K, xs, lane);
#pragma unroll
            for (int tt = 0; tt < 16; ++tt) { const float xr = xs[tt * S5_XP + lane], xi = xs[tt * S5_XP + 64 + lane];
                const float nr = K.ar * hr - K.ai * hi_ + xr, ni = K.ar * hi_ + K.ai * hr + xi; hr = nr; hi_ = ni; }
            ucur = unxt;
        }
        f32x2w o = {hr, hi_};
        *(f32x2w*)(hend + ((size_t)((b * S5_NG + g) * NCHUNK + c) * S5_N + lane) * 2) = o;
    }
}
__device__ __forceinline__ void s5_pass2(const Ctx& C, unsigned char* ws, const float* const* in, int j) {
    const bf16* proj = (const bf16*)(ws + WS_PROJ);
    const float* hend = (const float*)(ws + WS_S5H);
    float* GF = (float*)(ws + WS_GF); bf16* GB = (bf16*)(ws + WS_GB);
    const int lane = C.lane; const float half = opaque_f(0.5f);
    LAS float* xs = (LAS float*)C.wl;
    LAS unsigned char* hs = C.wl + 16 * S5_XP * 4;
    const int per = (BATCH * S5_NG * NCHUNK + C.ngw - 1) / C.ngw, u0 = C.gw * per;
    int gk = -1; S5Coef K; bf16x8 cf[4]; float dsk = 0.f;
    const int p = lane & 15, kq = lane >> 4;
    for (int u = u0; u < u0 + per && u < BATCH * S5_NG * NCHUNK; ++u) {
        const int c = u % NCHUNK, g = (u / NCHUNK) % S5_NG, b = u / (NCHUNK * S5_NG);
        if (g != gk) { s5_load_coef(ws, j, g, lane, K); gk = g;
#pragma unroll
            for (int ks = 0; ks < 4; ++ks) { const int k0 = 32 * ks + 8 * kq; const bool im = k0 >= 64;
                const float* src = (im ? INP(16) : INP(15)) + ((size_t)((j * S5_NG + g) * S5_P + p)) * S5_N + (k0 & 63);
                const f32x4 a = *(const f32x4*)src, bq = *(const f32x4*)(src + 4); const float sg = im ? -1.f : 1.f;
                v4u w; w.x = pk2(sg * a[0], sg * a[1]); w.y = pk2(sg * a[2], sg * a[3]); w.z = pk2(sg * bq[0], sg * bq[1]); w.w = pk2(sg * bq[2], sg * bq[3]); cf[ks] = __builtin_bit_cast(bf16x8, w); }
            dsk = INP(17)[j * S5_W + g * S5_P + p]; }
        float pr = K.ar, pi = K.ai;
#pragma unroll
        for (int q = 0; q < 6; ++q) { const float nr = pr * pr - pi * pi, tq = pr * pi; pr = nr; pi = tq + tq; }
        float hr = 0.f, hi_ = 0.f;
        const float* he = hend + ((size_t)((b * S5_NG + g) * NCHUNK) * S5_N + lane) * 2;
        for (int c0 = 0; c0 < c; c0 += 8) {
            f32x2w e[8];
#pragma unroll
            for (int k = 0; k < 8; ++k) { const int cc = (c0 + k < c) ? c0 + k : c - 1; e[k] = *(const f32x2w*)(he + (size_t)cc * S5_N * 2); }
#pragma unroll
            for (int k = 0; k < 8; ++k) if (c0 + k < c) { const float nr = pr * hr - pi * hi_ + e[k].x, ni = pr * hi_ + pi * hr + e[k].y; hr = nr; hi_ = ni; }
        }
        const size_t row0 = (size_t)b * SEQ + c * CHUNK;
        const bf16* up = proj + row0 * EVEN_IN + (A_Q + 2 * A_KV) + g * S5_P;
        v4u ucur = s5_load_u1(up, 0, lane);
#pragma unroll 1
        for (int tb = 0; tb < CHUNK / 16; ++tb) {
            const v4u unxt = s5_load_u1(up, tb < 3 ? tb + 1 : 3, lane);
            s5_xu_block(ucur, K, xs, lane); ucur = unxt;
            unsigned short us[4];
#pragma unroll
            for (int i = 0; i < 4; ++i) us[i] = up[(size_t)(16 * tb + 4 * kq + i) * EVEN_IN + p];
#pragma unroll
            for (int tt = 0; tt < 16; ++tt) { const float xr = xs[tt * S5_XP + lane], xi = xs[tt * S5_XP + 64 + lane];
                const float nr = K.ar * hr - K.ai * hi_ + xr, ni = K.ar * hi_ + K.ai * hr + xi; hr = nr; hi_ = ni;
                const unsigned w = pk2(hr, hi_);
                *(LAS unsigned short*)(hs + tt * 256 + ((((lane >> 3)) ^ tt) << 4) + (lane & 7) * 2) = (unsigned short)(w & 0xffffu);
                *(LAS unsigned short*)(hs + tt * 256 + ((((lane >> 3) + 8) ^ tt) << 4) + (lane & 7) * 2) = (unsigned short)(w >> 16); }
            f32x4 y = {0.f, 0.f, 0.f, 0.f};
#pragma unroll
            for (int ks = 0; ks < 4; ++ks) { const int t = lane & 15;
                const bf16x8 af = *(const LAS bf16x8*)(hs + t * 256 + (((4 * ks + kq) ^ t) << 4));
                y = __builtin_amdgcn_mfma_f32_16x16x32_bf16(af, cf[ks], y, 0, 0, 0); }
#pragma unroll
            for (int i = 0; i < 4; ++i) { const int t = 16 * tb + 4 * kq + i;
                const float uu = bf2f((short)us[i]);
                const float gg = gelu_tanh(y[i] + dsk * uu, half);
                GF[(row0 + t) * S5_W + g * S5_P + p] = gg;
                GB[(row0 + t) * S5_W + g * S5_P + p] = (bf16)(pk2(gg, 0.f) & 0xffffu); }
        }
    }
}

__device__ __forceinline__ void lru_gates(const Ctx& C, unsigned char* ws, const float* const* in, int j) {
    const bf16* proj = (const bf16*)(ws + WS_PROJ);
    const bf16* wt = (const bf16*)(ws + WS_W_LRU) + (size_t)(2 * j) * LRU_BD * LRU_W;
    float* LG[2] = {(float*)(ws + WS_LGA), (float*)(ws + WS_LGX)};
    const float* cw = INP(22) + (size_t)j * 4 * LRU_W; const float* cb = INP(23) + (size_t)j * LRU_W;
    for (int u = C.gw; u < (M / 32) * LRU_NB; u += C.ngw) {
        int lane = C.lane; asm volatile("" : "+v"(lane));
        const int r32 = lane & 31, hi = lane >> 5;
        const int hb = u % LRU_NB, rt = u / LRU_NB;
        LAS unsigned char* xt = C.wl;
        LAS float* wl5 = (LAS float*)(C.wl + 35 * 256);
        { const int tloc0 = (rt * 32) % SEQ;
          v4u xv[9];
#pragma unroll
          for (int i = 0; i < 9; ++i) { const int n = lane + 64 * i, jr = n >> 4, chk = n & 15; const bool ok = (n < 35 * 16) && (tloc0 - 3 + jr >= 0);
              xv[i] = *(const v4u*)(proj + ((size_t)rt * 32 + (ok ? jr - 3 : 0)) * ODD_IN + 3 * C_W + hb * LRU_BD + chk * 8);
              if (!ok) { xv[i].x = 0u; xv[i].y = 0u; xv[i].z = 0u; xv[i].w = 0u; } }
          f32x4 wv[3];
#pragma unroll
          for (int i = 0; i < 3; ++i) { const int n = lane + 64 * i, tap = n >> 5, c4 = (n & 31) * 4;
              wv[i] = (n < 160) ? *(const f32x4*)((tap < 4 ? cw + tap * LRU_W : cb) + hb * LRU_BD + c4) : (f32x4){0.f, 0.f, 0.f, 0.f}; }
#pragma unroll
          for (int i = 0; i < 9; ++i) { const int n = lane + 64 * i, jr = n >> 4, chk = n & 15; if (n < 35 * 16) *(LAS v4u*)(xt + off_b(jr, chk)) = xv[i]; }
#pragma unroll
          for (int i = 0; i < 3; ++i) { const int n = lane + 64 * i; if (n < 160) *(LAS f32x4*)(wl5 + n * 4) = wv[i]; }
        }
        bf16x8 xf[8];
#pragma unroll
        for (int s = 0; s < 8; ++s) { const int ci = 16 * s + 8 * hi;
            float a[8];
            { const f32x4 b0 = *(const LAS f32x4*)(wl5 + 4 * 128 + ci), b1 = *(const LAS f32x4*)(wl5 + 4 * 128 + ci + 4); a[0] = b0[0]; a[1] = b0[1]; a[2] = b0[2]; a[3] = b0[3]; a[4] = b1[0]; a[5] = b1[1]; a[6] = b1[2]; a[7] = b1[3]; }
#pragma unroll
            for (int k = 0; k < 4; ++k) {
                const v4u x = *(const LAS v4u*)(xt + off_b(r32 + k, 2 * s + hi));
                const f32x4 w0 = *(const LAS f32x4*)(wl5 + k * 128 + ci), w1 = *(const LAS f32x4*)(wl5 + k * 128 + ci + 4);
                a[0] += w0[0] * bflo(x.x); a[1] += w0[1] * bfhi(x.x); a[2] += w0[2] * bflo(x.y); a[3] += w0[3] * bfhi(x.y);
                a[4] += w1[0] * bflo(x.z); a[5] += w1[1] * bfhi(x.z); a[6] += w1[2] * bflo(x.w); a[7] += w1[3] * bfhi(x.w); }
            v4u w; w.x = pk2(a[0], a[1]); w.y = pk2(a[2], a[3]); w.z = pk2(a[4], a[5]); w.w = pk2(a[6], a[7]); xf[s] = __builtin_bit_cast(bf16x8, w); }
        bf16x8 idf[2];
#pragma unroll
        for (int q = 0; q < 2; ++q) { const int jj = r32 - 16 * q - 8 * hi;
#pragma unroll
            for (int e8 = 0; e8 < 8; ++e8) idf[q][e8] = (short)(e8 == jj ? 0x3F80 : 0); }
        const float* bias_a = INP(25) + (size_t)j * LRU_W + hb * LRU_BD; const float* bias_x = INP(27) + (size_t)j * LRU_W + hb * LRU_BD;
        const float* lam = INP(28) + (size_t)j * LRU_W + hb * LRU_BD;
        float ba[4], bx[4], nl[4];
#pragma unroll
        for (int cbk = 0; cbk < 4; ++cbk) { ba[cbk] = bias_a[32 * cbk + r32]; bx[cbk] = bias_x[32 * cbk + r32]; nl[cbk] = -lam[32 * cbk + r32]; }
        const bf16* wbase = wt + (size_t)r32 * LRU_W + hb * LRU_BD + 8 * hi;
#pragma unroll
        for (int cbk = 0; cbk < 4; ++cbk) {
            f32x16 acc_a, acc_x, acc_c;
#pragma unroll
            for (int r = 0; r < 16; ++r) { acc_a[r] = 0.f; acc_x[r] = 0.f; acc_c[r] = 0.f; }
            bf16x8 wa[8], wx[8];
#pragma unroll
            for (int s = 0; s < 8; ++s) { const bf16* wn = wbase + (size_t)32 * cbk * LRU_W + 16 * s; wa[s] = *(const bf16x8*)wn; wx[s] = *(const bf16x8*)(wn + (size_t)LRU_BD * LRU_W); }
            asm volatile("" :: "v"(wa[0]), "v"(wa[1]), "v"(wa[2]), "v"(wa[3]), "v"(wa[4]), "v"(wa[5]), "v"(wa[6]), "v"(wa[7]), "v"(wx[0]), "v"(wx[1]), "v"(wx[2]), "v"(wx[3]), "v"(wx[4]), "v"(wx[5]), "v"(wx[6]), "v"(wx[7]));
#pragma unroll
            for (int s = 0; s < 8; ++s) {
                acc_a = __builtin_amdgcn_mfma_f32_32x32x16_bf16(xf[s], wa[s], acc_a, 0, 0, 0);
                acc_x = __builtin_amdgcn_mfma_f32_32x32x16_bf16(xf[s], wx[s], acc_x, 0, 0, 0); }
            acc_c = __builtin_amdgcn_mfma_f32_32x32x16_bf16(xf[2 * cbk], idf[0], acc_c, 0, 0, 0);
            acc_c = __builtin_amdgcn_mfma_f32_32x32x16_bf16(xf[2 * cbk + 1], idf[1], acc_c, 0, 0, 0);
            const float spl = fmaxf(nl[cbk], 0.f) + __logf(1.0f + __expf(-fabsf(nl[cbk])));
            LAS float* ta = (LAS float*)C.wl; LAS float* td = ta + 32 * 64;
#pragma unroll
            for (int r = 0; r < 16; ++r) {
                const float rg = sigmoid_f(acc_a[r] + ba[cbk]), ig = sigmoid_f(acc_x[r] + bx[cbk]);
                const float la = -8.0f * rg * spl, a = __expf(la), a2 = a * a;
                const float om_s = -la * (2.0f + la * (2.0f + la * (1.3333334f + la * 0.6666667f))), om_d = 1.0f - a2;
                const unsigned msk = (la > -0.05f) ? 0xffffffffu : 0u;
                const float om = __uint_as_float((__float_as_uint(om_s) & msk) | (__float_as_uint(om_d) & ~msk));
                ta[crow(r, hi) * 64 + 32 * (cbk & 1) + r32] = a; td[crow(r, hi) * 64 + 32 * (cbk & 1) + r32] = __builtin_amdgcn_sqrtf(om) * (ig * acc_c[r]); }
            if (cbk & 1) {
                float* oa = LG[0] + (size_t)rt * 32 * LRU_W + hb * LRU_BD + 64 * (cbk >> 1); float* od = LG[1] + (size_t)rt * 32 * LRU_W + hb * LRU_BD + 64 * (cbk >> 1);
#pragma unroll
                for (int i = 0; i < 8; ++i) { const int row = 4 * i + (lane >> 4), c4 = (lane & 15) * 4;
                    *(f32x4*)(oa + (size_t)row * LRU_W + c4) = *(const LAS f32x4*)(ta + row * 64 + c4);
                    *(f32x4*)(od + (size_t)row * LRU_W + c4) = *(const LAS f32x4*)(td + row * 64 + c4); }
            }
        }
    }
}
template <bool FINAL> struct LruIn { f32x2w a[16], d[16]; unsigned xg[16]; };
template <bool FINAL> __device__ __forceinline__ void lru_load(LruIn<FINAL>& I, const float* pa, const float* pd, const bf16* xgp, int t0) {
#pragma unroll
    for (int k = 0; k < 16; ++k) { I.a[k] = *(const f32x2w*)(pa + (size_t)(t0 + k) * LRU_W); I.d[k] = *(const f32x2w*)(pd + (size_t)(t0 + k) * LRU_W); if (FINAL) I.xg[k] = *(const unsigned*)(xgp + (size_t)(t0 + k) * ODD_IN); }
}
template <bool FINAL> __device__ __forceinline__ void lru_scan(const Ctx& C, unsigned char* ws, const float* const* in, int j) {
    const bf16* proj = (const bf16*)(ws + WS_PROJ);
    const float* LGA = (const float*)(ws + WS_LGA); const float* LGX = (const float*)(ws + WS_LGX);
    float* SUM = (float*)(ws + WS_LSUM); bf16* cat = (bf16*)(ws + WS_CAT);
    const float half = opaque_f(0.5f);
    for (int u = C.gw; u < BATCH * NCHUNK * (LRU_W / 128); u += C.ngw) {
        const int chg = u % (LRU_W / 128), c = (u / (LRU_W / 128)) % NCHUNK, b = u / ((LRU_W / 128) * NCHUNK), ch = chg * 128 + 2 * C.lane;
        const size_t row0 = (size_t)b * SEQ + c * CHUNK;
        const bf16* xgp = proj + row0 * ODD_IN + 3 * C_W + LRU_W + ch; const float* pa = LGA + row0 * LRU_W + ch; const float* pd = LGX + row0 * LRU_W + ch;
        float h0 = 0.f, h1 = 0.f, p0 = 1.f, p1 = 1.f;
        if (FINAL) { const float* sm = SUM + ((size_t)b * NCHUNK * LRU_W + ch) * 2;
            for (int c0 = 0; c0 < c; c0 += 16) {
                f32x4 s[16];
#pragma unroll
                for (int k = 0; k < 16; ++k) { const int cc = (c0 + k < c) ? c0 + k : c - 1; s[k] = *(const f32x4*)(sm + (size_t)cc * LRU_W * 2); }
#pragma unroll
                for (int k = 0; k < 16; ++k) if (c0 + k < c) { h0 = s[k][0] * h0 + s[k][1]; h1 = s[k][2] * h1 + s[k][3]; }
            } }
        bf16* op = cat + row0 * ODD_OUT + C_W + ch;
#pragma unroll 1
        for (int t0 = 0; t0 < CHUNK; t0 += 16) {
            LruIn<FINAL> I; lru_load<FINAL>(I, pa, pd, xgp, t0);
            unsigned o_[16];
#pragma unroll
            for (int k = 0; k < 16; ++k) { h0 = I.a[k].x * h0 + I.d[k].x; h1 = I.a[k].y * h1 + I.d[k].y; p0 *= I.a[k].x; p1 *= I.a[k].y;
                if (FINAL) o_[k] = pk2(h0 * gelu_tanh(bflo(I.xg[k]), half), h1 * gelu_tanh(bfhi(I.xg[k]), half)); }
            if (FINAL) {
#pragma unroll
                for (int k = 0; k < 16; ++k) *(unsigned*)(op + (size_t)(t0 + k) * ODD_OUT) = o_[k]; }
        }
        if (!FINAL) { f32x4 s = {p0, h0, p1, h1}; *(f32x4*)(SUM + ((size_t)(b * NCHUNK + c) * LRU_W + ch) * 2) = s; }
    }
}

__device__ __forceinline__ void ffn_fixup(const Ctx& C, unsigned char* ws, const float* const* in, int layer) {
    const float* halo = (const float*)(ws + WS_HALO); bf16* act = (bf16*)(ws + WS_ACT);
    const float* cw = INP(30) + (size_t)layer * 3 * 2 * DFF; const float* cb = INP(31) + (size_t)layer * 2 * DFF;
    for (int e = C.gt; e < (M / 64) * 2 * (DFF / 4); e += C.ngt) {
        const int ch = (e % (DFF / 4)) * 4, jr = (e / (DFF / 4)) & 1, blk = e / (2 * (DFF / 4));
        const bool has_prev = ((blk * 64) % SEQ) != 0;
        f32x4 v[2][3];
#pragma unroll
        for (int gu = 0; gu < 2; ++gu) {
            const f32x4 z = {0.f, 0.f, 0.f, 0.f};
            const f32x4 cur0 = *(const f32x4*)(halo + ((size_t)(blk * 4 + 0) * 2 + gu) * DFF + ch);
            f32x4 p3 = z, p2 = z;
            if (has_prev) { p3 = *(const f32x4*)(halo + ((size_t)((blk - 1) * 4 + 3) * 2 + gu) * DFF + ch); p2 = *(const f32x4*)(halo + ((size_t)((blk - 1) * 4 + 2) * 2 + gu) * DFF + ch); }
            if (jr == 0) { v[gu][0] = p2; v[gu][1] = p3; v[gu][2] = cur0; }
            else { v[gu][0] = p3; v[gu][1] = cur0; v[gu][2] = *(const f32x4*)(halo + ((size_t)(blk * 4 + 1) * 2 + gu) * DFF + ch); }
        }
        f32x4 o;
        const f32x4 wg0 = *(const f32x4*)(cw + ch), wg1 = *(const f32x4*)(cw + 2 * DFF + ch), wg2 = *(const f32x4*)(cw + 4 * DFF + ch), bg = *(const f32x4*)(cb + ch);
        const f32x4 wu0 = *(const f32x4*)(cw + DFF + ch), wu1 = *(const f32x4*)(cw + 3 * DFF + ch), wu2 = *(const f32x4*)(cw + 5 * DFF + ch), bu = *(const f32x4*)(cb + DFF + ch);
#pragma unroll
        for (int q = 0; q < 4; ++q) { const float gc = bg[q] + wg0[q] * v[0][0][q] + wg1[q] * v[0][1][q] + wg2[q] * v[0][2][q], uc = bu[q] + wu0[q] * v[1][0][q] + wu1[q] * v[1][1][q] + wu2[q] * v[1][2][q];
            o[q] = gc * sigmoid_f(gc) * uc; }
        v2u w; w.x = pk2(o[0], o[1]); w.y = pk2(o[2], o[3]);
        *(v2u*)(act + (size_t)(blk * 64 + jr) * DFF + ch) = w;
    }
}

__device__ __forceinline__ void final_norm(const Ctx& C, const bf16* hb, const float* ssq, const float* gain, float* out) {
    f32x4 gv[16];
#pragma unroll
    for (int jj = 0; jj < 16; ++jj) gv[jj] = ((const f32x4*)gain + C.lane)[64 * jj];
    for (int m = C.gw; m < M; m += C.ngw) {
        float s = ssq[(size_t)m * 64 + C.lane];
        s += swz_xor<1>(s); s += swz_xor<2>(s); s += swz_xor<4>(s); s += swz_xor<8>(s); s += swz_xor<16>(s); s = add_xor32(s);
        const float rs = rsqrtf(s * (1.0f / DM) + 1e-6f);
        const v2u* hr = (const v2u*)(hb + (size_t)m * DM) + C.lane; f32x4* o4 = (f32x4*)(out + (size_t)m * DM) + C.lane;
        v2u hv[16];
#pragma unroll
        for (int jj = 0; jj < 16; ++jj) hv[jj] = hr[64 * jj];
        asm volatile("" :: "v"(hv[0]), "v"(hv[1]), "v"(hv[2]), "v"(hv[3]), "v"(hv[4]), "v"(hv[5]), "v"(hv[6]), "v"(hv[7]), "v"(hv[8]), "v"(hv[9]), "v"(hv[10]), "v"(hv[11]), "v"(hv[12]), "v"(hv[13]), "v"(hv[14]), "v"(hv[15]));
#pragma unroll
        for (int jj = 0; jj < 16; ++jj) { f32x4 v; v[0] = bflo(hv[jj].x); v[1] = bfhi(hv[jj].x); v[2] = bflo(hv[jj].y); v[3] = bfhi(hv[jj].y); o4[64 * jj] = v * rs * gv[jj]; }
    }
}

struct Args { const float* in[35]; float* out; unsigned char* ws; int ph_lo, ph_hi, sub, pad; };
static_assert(sizeof(Args) == 35 * 8 + 8 + 8 + 16, "Args has no padding");

__global__ void __launch_bounds__(NTHREADS, 2) hybrid_fwd(Args args) {
    extern __shared__ __attribute__((aligned(16))) unsigned char lds_raw[];
    LAS unsigned char* const lds_base = (LAS unsigned char*)lds_raw;
    const int G = gridDim.x;
    const int wave_id = __builtin_amdgcn_readfirstlane((int)threadIdx.x >> 6);
    unsigned char* const ws_arg = args.ws;
#define ENV unsigned char* ws = launder_u8(ws_arg); const float* const* in = (const float* const*)launder_u8((unsigned char*)__builtin_amdgcn_kernarg_segment_ptr()); (void)in; (void)ws; \
    const Ctx C = make_ctx(lds_base, wave_id); (void)C
#define MISC ((volatile LAS unsigned*)(lds_base + MISC_OFF))
    for (int u = threadIdx.x; u < (LDS_BYTES - MISC_OFF) / 4; u += NTHREADS) ((LAS unsigned*)(lds_base + MISC_OFF))[u] = 0u;
    __syncthreads();
    const int lo = args.ph_lo, hi = args.ph_hi, sub = args.sub;
    const bool one_launch = (hi - lo) > 1;
    if (one_launch) (void)xcd_barrier_post((unsigned*)(ws_arg + WS_CTL) + CW_BAR, MISC + 8);
#ifndef PH_MASK
#define PH_MASK 0xffffffffu
#endif
#define PH_ON(k) ((k) == 0 ? ((PH_MASK >> 15) & 1u) : (k) == 65 ? ((PH_MASK >> 31) & 1u) : ((PH_MASK >> ((((k) - 1) & 15) + ((((k) - 1) >> 4) & 1) * 16)) & 1u))
#define IN(k) (PH_ON(k) && lo <= (k) && (k) < hi)
#define SEAM(k) do { if (hi > (k) + 1) { XcdBarrier bar_; bar_.bar = (unsigned*)(launder_u8(ws_arg) + WS_CTL) + CW_BAR; bar_.x = xb_xcc_id(); bar_.st = MISC + 8; xcd_barrier(bar_); } } while (0)
    LAS unsigned char* const ring = lds_base + RING_OFF;

    if (IN(0)) { ENV; p0_prologue(C, in, ws); SEAM(0); }

    int cur = 0;
    int hcur = 0;
#define HBP(i)  ((bf16*)(ws + WS_HB0 + (size_t)(i) * (WS_HB1 - WS_HB0)))
#define SSQP(i) ((float*)(ws + WS_SSQ0 + (size_t)(i) * (WS_SSQ1 - WS_SSQ0)))
#define HP(i)   ((float*)(ws + WS_H0 + (size_t)(i) * (WS_H1 - WS_H0)))
#define PROJ ((bf16*)(ws + WS_PROJ))
#define CAT  ((bf16*)(ws + WS_CAT))

#pragma unroll 1
    for (int layer = 0; layer < DEPTH; ++layer) {
        const int pb = 1 + 16 * layer, j = layer >> 1;
        if ((layer & 1) == 0) {
            if (IN(pb + 0)) { ENV;
                pg8::Gemm g{HBP(cur), (const bf16*)(ws + WS_W_ABIN) + (size_t)j * EVEN_IN * DM, M, EVEN_IN, DM}; pg8::StaticOrder S; S.init(M, EVEN_IN, G, (int)blockIdx.x);
                pg8::EpiRowScale<true> E{PROJ, EVEN_IN, SSQP(cur), (pg8::lds_f32*)(lds_base + RING_BYTES)};
                pg8::gemm_phase<pg8::EpiRowScale<true>, pg8::StaticOrder, true, true>(ring, g, S, E, C.tid);
                SEAM(pb + 0);
            }
            if (IN(pb + 1)) { ENV;
                s5_pass1(C, ws, j);
                SEAM(pb + 1);
            }
            if (IN(pb + 2)) { ENV; s5_pass2(C, ws, in, j); SEAM(pb + 2); }
            if (IN(pb + 3)) { ENV;
                pg8::Gemm g{(const bf16*)(ws + WS_GB), (const bf16*)(ws + WS_W_GLU) + (size_t)j * S5_W * S5_W, M, S5_W, S5_W}; pg8::StaticOrder S; S.init(M, S5_W, G, (int)blockIdx.x);
                pg8::EpiGlu E{(const float*)(ws + WS_GF), INP(19) + j * S5_W, CAT, EVEN_OUT, A_Q};
                pg8::gemm_phase<pg8::EpiGlu, pg8::StaticOrder, true, true>(ring, g, S, E, C.tid);
                if (sub != 1) { const float* rope = (const float*)(ws + WS_ROPE); const float* sinks = INP(9) + j * A_HEADS;
                    unsigned* cnt = (unsigned*)(ws + WS_CTL) + CW_SWA + 64 * j;
                    for (;;) { unsigned u = 0; if (C.lane == 0) u = __hip_atomic_fetch_add(cnt, 1u, __ATOMIC_RELAXED, __HIP_MEMORY_SCOPE_AGENT); u = __builtin_amdgcn_readfirstlane(u);
                        if (u >= (unsigned)(BATCH * A_HEADS * (SEQ / 32))) break;
                        const int qt = u % (SEQ / 32), hq = (u / (SEQ / 32)) % A_HEADS, b = u / ((SEQ / 32) * A_HEADS);
                        swa_unit(C, PROJ, rope, sinks, CAT, b, hq, qt); } }
                SEAM(pb + 3);
            }
            if (IN(pb + 4)) { ENV;
                pg8::Gemm g{CAT, (const bf16*)(ws + WS_W_ABOUT) + (size_t)j * DM * EVEN_OUT, M, DM, EVEN_OUT}; pg8::StaticOrder S; S.init(M, DM, G, (int)blockIdx.x);
                pg8::EpiResidual E{HBP(cur), HBP(cur ^ 1), SSQP(cur ^ 1)};
                pg8::gemm_phase<pg8::EpiResidual, pg8::StaticOrder, true, true>(ring, g, S, E, C.tid);
                SEAM(pb + 4);
            }
        } else {
            if (IN(pb + 0)) { ENV;
                pg8::Gemm g{HBP(cur), (const bf16*)(ws + WS_W_CDIN) + (size_t)j * ODD_IN * DM, M, ODD_IN, DM}; pg8::StaticOrder S; S.init(M, ODD_IN, G, (int)blockIdx.x);
                pg8::EpiRowScale<true> E{PROJ, ODD_IN, SSQP(cur), (pg8::lds_f32*)(lds_base + RING_BYTES)};
                pg8::gemm_phase<pg8::EpiRowScale<true>, pg8::StaticOrder, true, true>(ring, g, S, E, C.tid);
                SEAM(pb + 0);
            }
            if (IN(pb + 1)) { ENV;
                if (sub != 2) for (int u = C.gw; u < BATCH * C_HEADS * (SEQ / 64); u += C.ngw) { const int q0 = u % (SEQ / 64), bh = u / (SEQ / 64), b = bh / C_HEADS, h = bh % C_HEADS;
                    sb_unit(C, PROJ, CAT, b, h, q0); sb_unit(C, PROJ, CAT, b, h, SEQ / 32 - 1 - q0); }
                if (sub != 1) lru_gates(C, ws, in, j);
                SEAM(pb + 1);
            }
            if (IN(pb + 2)) { ENV; lru_scan<false>(C, ws, in, j); SEAM(pb + 2); }
            if (IN(pb + 3)) { ENV; lru_scan<true>(C, ws, in, j); SEAM(pb + 3); }
            if (IN(pb + 4)) { ENV;
                pg8::Gemm g{CAT, (const bf16*)(ws + WS_W_CDOUT) + (size_t)j * DM * ODD_OUT, M, DM, ODD_OUT}; pg8::StaticOrder S; S.init(M, DM, G, (int)blockIdx.x);
                pg8::EpiResidual E{HBP(cur), HBP(cur ^ 1), SSQP(cur ^ 1)};
                pg8::gemm_phase<pg8::EpiResidual, pg8::StaticOrder, true, true>(ring, g, S, E, C.tid);
                SEAM(pb + 4);
            }
        }
        cur ^= 1;
        if (IN(pb + 5)) { ENV;
            { pg8::Gemm g{HBP(cur), (const bf16*)(ws + WS_W_UP) + (size_t)layer * 2 * DFF * DM, M, 2 * DFF, DM}; pg8::StaticOrder S; S.init(M, 2 * DFF, G, (int)blockIdx.x);
              pg8::EpiUpConv E{(bf16*)(ws + WS_ACT), SSQP(cur), INP(30) + (size_t)layer * 3 * 2 * DFF, INP(31) + (size_t)layer * 2 * DFF, (float*)(ws + WS_HALO), (pg8::lds_f32*)(lds_base + RING_BYTES)};
              pg8::gemm_phase<pg8::EpiUpConv, pg8::StaticOrder, true, true>(ring, g, S, E, C.tid); }
            { ENV; pg8::Gemm g{(const bf16*)(ws + WS_PB) + (size_t)layer * M * PLE, (const bf16*)(ws + WS_W_PROJ) + (size_t)layer * DM * PLE, M, DM, PLE}; pg8::StaticOrder S; S.init(M, DM, G, (int)blockIdx.x);
              pg8::EpiRowScale<false> E{(bf16*)(ws + WS_PE), DM, nullptr, nullptr};
              pg8::gemm_phase<pg8::EpiRowScale<false>, pg8::StaticOrder, true, true>(ring, g, S, E, C.tid); }
            SEAM(pb + 5);
        }
        if (IN(pb + 6)) { ENV; ffn_fixup(C, ws, in, layer); SEAM(pb + 6); }
        if (IN(pb + 7)) { ENV;
            pg8::Gemm g{(const bf16*)(ws + WS_ACT), (const bf16*)(ws + WS_W_DOWN) + (size_t)layer * DM * DFF, M, DM, DFF}; pg8::StaticOrder S; S.init(M, DM, G, (int)blockIdx.x);
            pg8::EpiResidual E{HBP(cur), HBP(cur ^ 1), SSQP(cur ^ 1)};
            pg8::gemm_phase<pg8::EpiResidual, pg8::StaticOrder, true, true>(ring, g, S, E, C.tid);
            SEAM(pb + 7);
        }
        cur ^= 1;
        if (IN(pb + 8)) { ENV;
            pg8::Gemm g{HBP(cur), (const bf16*)(ws + WS_W_GATE) + (size_t)layer * DM * DM, M, DM, DM}; pg8::StaticOrder S; S.init(M, DM, G, (int)blockIdx.x);
            pg8::EpiGate E{HBP(cur), HBP(cur ^ 1), SSQP(cur), SSQP(cur ^ 1), (const bf16*)(ws + WS_PE), (pg8::lds_f32*)(lds_base + RING_BYTES)};
            pg8::gemm_phase<pg8::EpiGate, pg8::StaticOrder, true, true>(ring, g, S, E, C.tid);
            SEAM(pb + 8);
        }
        cur ^= 1; hcur ^= 1;
    }
    if (IN(65)) { ENV; final_norm(C, HBP(cur), SSQP(cur), INP(6), args.out); }
#undef IN
#undef SEAM
}

#ifndef MK_PER_PHASE
#define MK_PER_PHASE 0
#endif
extern "C" void kernel_launch(void* const* d_in, const int* in_sizes, int n_in, void* d_out, int out_size, void* d_ws, size_t ws_size, hipStream_t stream) {
    static int grid = 0;
    if (grid == 0) {
        if (n_in != 35 || in_sizes[0] != M * DM || out_size != M * DM || ws_size < WS_END) {
            fprintf(stderr, "kernel_launch: built for 35 inputs, x/out of %d floats, >= %zu bytes of workspace; got n_in %d, in0 %d, out %d, ws %zu; nothing launched\n", M * DM, (size_t)WS_END, n_in, n_in > 0 ? in_sizes[0] : -1, out_size, ws_size);
            grid = -1; return; }
        int dev = 0, cus = 0, per_cu = 0;
        if (hipGetDevice(&dev) != hipSuccess || hipDeviceGetAttribute(&cus, hipDeviceAttributeMultiprocessorCount, dev) != hipSuccess) { fprintf(stderr, "kernel_launch: device query failed\n"); grid = -1; return; }
        if (hipFuncSetAttribute((const void*)hybrid_fwd, hipFuncAttributeMaxDynamicSharedMemorySize, LDS_BYTES) != hipSuccess) { fprintf(stderr, "kernel_launch: hipFuncSetAttribute failed\n"); grid = -1; return; }
        if (hipOccupancyMaxActiveBlocksPerMultiprocessor(&per_cu, (const void*)hybrid_fwd, NTHREADS, LDS_BYTES) != hipSuccess || per_cu < 1)
            fprintf(stderr, "kernel_launch: note: occupancy query reports %d workgroups per CU\n", per_cu);
        (void)hipGetLastError();
        grid = cus;
    }
    if (grid < 0) return;
    if (hipMemsetAsync((char*)d_ws + WS_CTL, 0, CTL_ZERO_BYTES, stream) != hipSuccess) { fprintf(stderr, "kernel_launch: memset failed\n"); return; }
    Args a{};
    for (int i = 0; i < 35; ++i) a.in[i] = (const float*)d_in[i];
    a.out = (float*)d_out; a.ws = (unsigned char*)d_ws;
#if MK_PER_PHASE
    for (int ph = 0; ph <= 65; ++ph) {
        const int k = (ph - 1) & 15;
        if (ph != 0 && ph != 65 && k > 8) continue;
        a.ph_lo = ph; a.ph_hi = ph + 1;
        hipLaunchKernelGGL(hybrid_fwd, dim3(grid), dim3(NTHREADS), LDS_BYTES, stream, a);
#if defined(PROBE_PHASE)
#ifndef PROBE_SUB
#define PROBE_SUB 0
#endif
        if (ph == PROBE_PHASE) { a.sub = PROBE_SUB; for (int r = 0; r < PROBE_REPS; ++r) hipLaunchKernelGGL(hybrid_fwd, dim3(grid), dim3(NTHREADS), LDS_BYTES, stream, a); a.sub = 0; }
#endif
    }
#else
    a.ph_lo = 0; a.ph_hi = 66;
    hipLaunchKernelGGL(hybrid_fwd, dim3(grid), dim3(NTHREADS), LDS_BYTES, stream, a);
#endif
    const hipError_t le = hipPeekAtLastError();
    if (le != hipSuccess) fprintf(stderr, "kernel_launch: launch failed: %s\n", hipGetErrorName(le));
}
```

```cpp
#include <hip/hip_runtime.h>
#include <cstdio>
#include <cstdint>
#include <cstddef>
namespace pg8 {
#define PG8_LAS __attribute__((address_space(3)))
typedef unsigned short bf16_t;
typedef short bf16x8 __attribute__((ext_vector_type(8)));
typedef float f32x4 __attribute__((ext_vector_type(4)));
typedef unsigned u32x4 __attribute__((ext_vector_type(4)));
constexpr int BM = 256, BK = 64, HALF = 128, HTB = HALF * BK * 2  , STAGE_BYTES = 8 * HTB, NXCD = 8, WGM = 8;

__host__ __device__ __forceinline__ int lds_byte(int r, int c) { const int st = (r >> 4) * 2 + (c >> 5), rr = r & 15, cc = c & 31, ob = rr * 64 + cc * 2; return st * 1024 + (ob ^ (((ob >> 9) & 1) << 5)); }
__host__ __device__ __forceinline__ void stage_rc(int b, int& R, int& C) { const int st = b / 1024, sb = b % 1024, swz = sb ^ (((sb >> 9) & 1) << 5); R = (st >> 1) * 16 + swz / 64; C = (st & 1) * 32 + (swz % 64) / 2; }
__host__ __device__ __forceinline__ int perm32(int rho) { const int n = rho >> 4, i = rho & 15; return 8 * (i >> 2) + 4 * n + (i & 3); }

struct Unit { int pm, pn; };
struct Gemm { const bf16_t* A; const bf16_t* Bt; int M, N, K; };

struct StaticOrder {
    int nM, nN, nwg, G, c;
    __host__ __device__ void init(int M, int N, int G_, int c_) { nM = M / BM; nN = N / BM; nwg = nM * nN; G = G_; c = c_; }
    __host__ __device__ bool next(int i, Unit& u) const {
        const long L = (long)i * G + c; if (L >= nwg) return false;
        int wgid = (int)L; { const int q = nwg / NXCD, r = nwg % NXCD, xcd = wgid % NXCD, off = wgid / NXCD; wgid = (xcd < r ? xcd * (q + 1) : r * (q + 1) + (xcd - r) * q) + off; }
        const int nig = WGM * nN, gid = wgid / nig, fm = gid * WGM, gsz = (nM - fm) < WGM ? (nM - fm) : WGM;
        u.pm = fm + ((wgid % nig) % gsz); u.pn = (wgid % nig) / gsz; return true;
    }
    __device__ __forceinline__ void a_ready(const Unit&) const {}
    __device__ __forceinline__ void done(const Unit&) const {}
};

__device__ __forceinline__ unsigned cvt_pk_bf16(float lo, float hi) { unsigned r; asm volatile("v_cvt_pk_bf16_f32 %0, %1, %2" : "=v"(r) : "v"(lo), "v"(hi)); return r; }
constexpr int MROWS = 8192;
typedef float f32x2v __attribute__((ext_vector_type(2)));
typedef __bf16 bf16x2v __attribute__((ext_vector_type(2)));
__device__ __forceinline__ unsigned pk2(float lo, float hi) { f32x2v v = {lo, hi}; bf16x2v b = __builtin_convertvector(v, bf16x2v); return __builtin_bit_cast(unsigned, b); }
__device__ __forceinline__ float bflo(unsigned w) { return __uint_as_float(w << 16); }
__device__ __forceinline__ float bfhi(unsigned w) { return __uint_as_float(w & 0xffff0000u); }
template <int MASK> __device__ __forceinline__ float swz_xor(float v) { static_assert(MASK > 0 && MASK < 32, "ds_swizzle bit mode"); return __int_as_float(__builtin_amdgcn_ds_swizzle(__float_as_int(v), (MASK << 10) | 0x1f)); }
__device__ __forceinline__ float add_xor32(float v) { const auto rr = __builtin_amdgcn_permlane32_swap(__float_as_uint(v), __float_as_uint(v), false, false); return __uint_as_float(rr[0]) + __uint_as_float(rr[1]); }
__device__ __forceinline__ float max_xor32(float v) { const auto rr = __builtin_amdgcn_permlane32_swap(__float_as_uint(v), __float_as_uint(v), false, false); return fmaxf(__uint_as_float(rr[0]), __uint_as_float(rr[1])); }
__device__ __forceinline__ float other_xor32(float v, int hi) { const auto rr = __builtin_amdgcn_permlane32_swap(__float_as_uint(v), __float_as_uint(v), false, false); return __uint_as_float(hi ? rr[0] : rr[1]); }
__device__ __forceinline__ void epi_lane(int& fr, int& fq) { unsigned z = 0u; asm volatile("" : "+s"(z)); const int l = (int)__builtin_amdgcn_mbcnt_hi(~0u, __builtin_amdgcn_mbcnt_lo(~0u, z)); fr = l & 15; fq = l >> 4; }
__device__ __forceinline__ float sigmoid_f(float x) { return __builtin_amdgcn_rcpf(1.0f + __expf(-x)); }
template <int PARTS = 2> __device__ __forceinline__ void rows_rstd(const float* ssq, int row0, int fq, float (&rs)[8]) {
#pragma unroll
    for (int h = 0; h < 2; ++h) {
        f32x4 v[4][4];
#pragma unroll
        for (int g = 0; g < 4; ++g) { const f32x4* p = (const f32x4*)(ssq + (unsigned)(row0 + h * HALF + g * 16) * 64u + (unsigned)(fq * 16));
#pragma unroll
            for (int q = 0; q < 4; ++q) v[g][q] = p[q]; }
        asm volatile("" :: "v"(v[0][0]), "v"(v[0][1]), "v"(v[0][2]), "v"(v[0][3]), "v"(v[1][0]), "v"(v[1][1]), "v"(v[1][2]), "v"(v[1][3]),
                           "v"(v[2][0]), "v"(v[2][1]), "v"(v[2][2]), "v"(v[2][3]), "v"(v[3][0]), "v"(v[3][1]), "v"(v[3][2]), "v"(v[3][3]));
#pragma unroll
        for (int g = 0; g < 4; ++g) { float t = 0.f;
#pragma unroll
            for (int q = 0; q < 4; ++q) { t += v[g][q][0]; t += v[g][q][1]; t += v[g][q][2]; t += v[g][q][3]; }
            t += swz_xor<16>(t); t = add_xor32(t); rs[h * 4 + g] = rsqrtf(t * (1.0f / 4096.0f) + 1e-6f); }
    }
}
typedef __attribute__((address_space(3))) float lds_f32;
__device__ __forceinline__ void rows_rstd_shared(const float* ssq, int rowbase, int wr, int wc, int fr, int fq, lds_f32* rl, float (&rs)[8]) {
    f32x4 v[2][4];
#pragma unroll
    for (int h = 0; h < 2; ++h) { const f32x4* p = (const f32x4*)(ssq + (unsigned)(rowbase + h * HALF + wc * 16 + fr) * 64u + (unsigned)(fq * 16));
#pragma unroll
        for (int q = 0; q < 4; ++q) v[h][q] = p[q]; }
    asm volatile("" :: "v"(v[0][0]), "v"(v[0][1]), "v"(v[0][2]), "v"(v[0][3]), "v"(v[1][0]), "v"(v[1][1]), "v"(v[1][2]), "v"(v[1][3]));
#pragma unroll
    for (int h = 0; h < 2; ++h) { float t = 0.f;
#pragma unroll
        for (int q = 0; q < 4; ++q) { t += v[h][q][0]; t += v[h][q][1]; t += v[h][q][2]; t += v[h][q][3]; }
        t += swz_xor<16>(t); t = add_xor32(t);
        if (fq == 0) rl[wr * 128 + h * 64 + wc * 16 + fr] = rsqrtf(t * (1.0f / 4096.0f) + 1e-6f); }
    asm volatile("s_waitcnt lgkmcnt(0)\n\ts_barrier" ::: "memory");
#pragma unroll
    for (int h = 0; h < 2; ++h)
#pragma unroll
        for (int g = 0; g < 4; ++g) rs[h * 4 + g] = rl[wr * 128 + h * 64 + g * 16 + fr];
}
__device__ __forceinline__ float sumsq8(const f32x4& v0, const f32x4& v1) { return (v0[0] * v0[0] + v0[1] * v0[1]) + (v0[2] * v0[2] + v0[3] * v0[3]) + (v1[0] * v1[0] + v1[1] * v1[1]) + (v1[2] * v1[2] + v1[3] * v1[3]); }
__device__ __forceinline__ u32x4 pack8(const f32x4& v0, const f32x4& v1) { u32x4 w; w.x = pk2(v0[0], v0[1]); w.y = pk2(v0[2], v0[3]); w.z = pk2(v1[0], v1[1]); w.w = pk2(v1[2], v1[3]); return w; }
template <bool SCALE> struct EpiRowScale {
    static constexpr bool PERM = true, AFTER_DRAIN = false;
    bf16_t* O; int ldc; const float* ssq; lds_f32* rl;
    __device__ __forceinline__ void operator()(const f32x4 (&acc)[2][2][4][2], const Unit& u, int wr, int wc, int fr, int fq) const {
        epi_lane(fr, fq);
        const int row0 = u.pm * BM + wr * 64 + fr, col0 = u.pn * BM + wc * 32 + 8 * fq;
        float rs[8];
        if (SCALE) rows_rstd_shared(ssq, u.pm * BM + wr * 64, wr, wc, fr, fq, rl, rs);
#pragma unroll
        for (int ai = 0; ai < 2; ++ai)
#pragma unroll
            for (int m = 0; m < 4; ++m) {
                const int row = row0 + ai * HALF + m * 16;
                const float r1 = SCALE ? rs[ai * 4 + m] : 1.0f;
                bf16_t* rowp = O + (size_t)row * ldc + col0;
#pragma unroll
                for (int bj = 0; bj < 2; ++bj) *(u32x4*)(rowp + bj * HALF) = pack8(acc[ai][bj][m][0] * r1, acc[ai][bj][m][1] * r1);
            }
    }
};
__device__ __forceinline__ f32x4 unlo4(const u32x4& w) { f32x4 v; v[0] = bflo(w.x); v[1] = bfhi(w.x); v[2] = bflo(w.y); v[3] = bfhi(w.y); return v; }
__device__ __forceinline__ f32x4 unhi4(const u32x4& w) { f32x4 v; v[0] = bflo(w.z); v[1] = bfhi(w.z); v[2] = bflo(w.w); v[3] = bfhi(w.w); return v; }
struct EpiResidual {
    static constexpr bool PERM = true, AFTER_DRAIN = false;
    const bf16_t* hin; bf16_t* hb; float* ssq_out;
    __device__ __forceinline__ void operator()(const f32x4 (&acc)[2][2][4][2], const Unit& u, int wr, int wc, int fr, int fq) const {
        epi_lane(fr, fq);
        const int row0 = u.pm * BM + wr * 64 + fr, col0 = u.pn * BM + wc * 32 + 8 * fq, part = u.pn * 4 + wc;
        u32x4 hw[2][8];
#pragma unroll
        for (int bj = 0; bj < 2; ++bj)
#pragma unroll
            for (int g = 0; g < 8; ++g) { const unsigned off = (unsigned)(row0 + (g >> 2) * HALF + (g & 3) * 16) * 4096u + (unsigned)(col0 + bj * HALF); hw[bj][g] = *(const u32x4*)(hin + off); }
        float ss[8];
#pragma unroll
        for (int g = 0; g < 8; ++g) ss[g] = 0.f;
#pragma unroll
        for (int bj = 0; bj < 2; ++bj)
#pragma unroll
            for (int g = 0; g < 8; ++g) { const unsigned off = (unsigned)(row0 + (g >> 2) * HALF + (g & 3) * 16) * 4096u + (unsigned)(col0 + bj * HALF);
                const u32x4 w = pack8(unlo4(hw[bj][g]) + acc[g >> 2][bj][g & 3][0], unhi4(hw[bj][g]) + acc[g >> 2][bj][g & 3][1]);
                *(u32x4*)(hb + off) = w;
                ss[g] += sumsq8(unlo4(w), unhi4(w)); }
#pragma unroll
        for (int g = 0; g < 8; ++g) { float t = ss[g]; t += swz_xor<16>(t); t = add_xor32(t); if (fq == 0) ssq_out[(unsigned)(row0 + (g >> 2) * HALF + (g & 3) * 16) * 64u + (unsigned)part] = t; }
    }
};
struct EpiGate {
    static constexpr bool PERM = true, AFTER_DRAIN = false;
    const bf16_t* hin; bf16_t* hb; const float* ssq_in; float* ssq_out; const bf16_t* pe; lds_f32* rl;
    __device__ __forceinline__ f32x4 gate4(const f32x4& h, const f32x4& a, float r1, unsigned w0, unsigned w1) const {
        f32x4 v; v[0] = h[0] + sigmoid_f(a[0] * r1) * bflo(w0); v[1] = h[1] + sigmoid_f(a[1] * r1) * bfhi(w0); v[2] = h[2] + sigmoid_f(a[2] * r1) * bflo(w1); v[3] = h[3] + sigmoid_f(a[3] * r1) * bfhi(w1); return v; }
    __device__ __forceinline__ void operator()(const f32x4 (&acc)[2][2][4][2], const Unit& u, int wr, int wc, int fr, int fq) const {
        epi_lane(fr, fq);
        const int row0 = u.pm * BM + wr * 64 + fr, col0 = u.pn * BM + wc * 32 + 8 * fq, part = u.pn * 4 + wc;
        float rs[8]; rows_rstd_shared(ssq_in, u.pm * BM + wr * 64, wr, wc, fr, fq, rl, rs);
        float ss[8];
#pragma unroll
        for (int g = 0; g < 8; ++g) ss[g] = 0.f;
#pragma unroll
        for (int bj = 0; bj < 2; ++bj) {
            u32x4 hw[8], pw[8];
#pragma unroll
            for (int g = 0; g < 8; ++g) { const unsigned off = (unsigned)(row0 + (g >> 2) * HALF + (g & 3) * 16) * 4096u + (unsigned)(col0 + bj * HALF); hw[g] = *(const u32x4*)(hin + off); pw[g] = *(const u32x4*)(pe + off); }
#pragma unroll
            for (int g = 0; g < 8; ++g) { const unsigned off = (unsigned)(row0 + (g >> 2) * HALF + (g & 3) * 16) * 4096u + (unsigned)(col0 + bj * HALF);
                const u32x4 w = pack8(gate4(unlo4(hw[g]), acc[g >> 2][bj][g & 3][0], rs[g], pw[g].x, pw[g].y), gate4(unhi4(hw[g]), acc[g >> 2][bj][g & 3][1], rs[g], pw[g].z, pw[g].w));
                *(u32x4*)(hb + off) = w;
                ss[g] += sumsq8(unlo4(w), unhi4(w)); }
        }
#pragma unroll
        for (int g = 0; g < 8; ++g) { float t = ss[g]; t += swz_xor<16>(t); t = add_xor32(t); if (fq == 0) ssq_out[(unsigned)(row0 + (g >> 2) * HALF + (g & 3) * 16) * 64u + (unsigned)part] = t; }
    }
};
template <int CTRL> __device__ __forceinline__ float dpp_f(float v) { return __int_as_float(__builtin_amdgcn_update_dpp(0, __float_as_int(v), CTRL, 0xf, 0xf, true)); }
struct EpiUpConv {
    static constexpr bool PERM = true, AFTER_DRAIN = false;
    bf16_t* act; const float* ssq; const float* cw; const float* cb; float* halo; lds_f32* rl;
    static constexpr int NCH = 10240;
    __device__ __forceinline__ void operator()(const f32x4 (&acc)[2][2][4][2], const Unit& u, int wr, int wc, int fr, int fq) const {
        epi_lane(fr, fq);
        const int row0 = u.pm * BM + wr * 64 + fr, ch0 = u.pn * HALF + wc * 32 + 8 * fq;
        float rs[8]; rows_rstd_shared(ssq, u.pm * BM + wr * 64, wr, wc, fr, fq, rl, rs);
        unsigned keep[8][2];
#pragma unroll
        for (int nh = 0; nh < 2; ++nh) {
            const int chn = ch0 + 4 * nh;
            const f32x4 wg0 = *(const f32x4*)(cw + chn), wg1 = *(const f32x4*)(cw + 2 * NCH + chn), wg2 = *(const f32x4*)(cw + 4 * NCH + chn), bg = *(const f32x4*)(cb + chn);
            const f32x4 wu0 = *(const f32x4*)(cw + NCH + chn), wu1 = *(const f32x4*)(cw + 3 * NCH + chn), wu2 = *(const f32x4*)(cw + 5 * NCH + chn), bu = *(const f32x4*)(cb + NCH + chn);
#pragma unroll
            for (int ai = 0; ai < 2; ++ai) {
                f32x4 pg = {0.f, 0.f, 0.f, 0.f}, pu = {0.f, 0.f, 0.f, 0.f};
#pragma unroll
                for (int m = 0; m < 4; ++m) {
                    const int row = row0 + ai * HALF + m * 16; const float r1 = rs[ai * 4 + m];
                    const f32x4 g = acc[ai][0][m][nh] * r1, uu = acc[ai][1][m][nh] * r1;
                    f32x4 o;
#pragma unroll
                    for (int q = 0; q < 4; ++q) {
                        float gc = bg[q] + wg2[q] * g[q], uc = bu[q] + wu2[q] * uu[q];
                        asm("s_nop 1\n\t"
                            "v_fmac_f32_dpp %0, %2, %6 row_shr:1 row_mask:0xf bank_mask:0xf bound_ctrl:1\n\t"
                            "v_fmac_f32_dpp %0, %3, %6 row_shl:15 row_mask:0xf bank_mask:0xf bound_ctrl:1\n\t"
                            "v_fmac_f32_dpp %0, %2, %7 row_shr:2 row_mask:0xf bank_mask:0xf bound_ctrl:1\n\t"
                            "v_fmac_f32_dpp %0, %3, %7 row_shl:14 row_mask:0xf bank_mask:0xf bound_ctrl:1\n\t"
                            "v_fmac_f32_dpp %1, %4, %8 row_shr:1 row_mask:0xf bank_mask:0xf bound_ctrl:1\n\t"
                            "v_fmac_f32_dpp %1, %5, %8 row_shl:15 row_mask:0xf bank_mask:0xf bound_ctrl:1\n\t"
                            "v_fmac_f32_dpp %1, %4, %9 row_shr:2 row_mask:0xf bank_mask:0xf bound_ctrl:1\n\t"
                            "v_fmac_f32_dpp %1, %5, %9 row_shl:14 row_mask:0xf bank_mask:0xf bound_ctrl:1"
                            : "+v"(gc), "+v"(uc) : "v"(g[q]), "v"(pg[q]), "v"(uu[q]), "v"(pu[q]), "v"(wg1[q]), "v"(wg0[q]), "v"(wu1[q]), "v"(wu0[q]));
                        o[q] = gc * sigmoid_f(gc) * uc; }
                    if (m == 0 && fr < 2) {
                        float* hp = halo + ((size_t)((row >> 6) * 4 + fr) * 2) * NCH + chn; *(f32x4*)hp = g; *(f32x4*)(hp + NCH) = uu; }
                    if (nh == 0) { keep[ai * 4 + m][0] = pk2(o[0], o[1]); keep[ai * 4 + m][1] = pk2(o[2], o[3]); }
                    else if (!(m == 0 && fr < 2)) { u32x4 w; w.x = keep[ai * 4 + m][0]; w.y = keep[ai * 4 + m][1]; w.z = pk2(o[0], o[1]); w.w = pk2(o[2], o[3]); *(u32x4*)(act + (size_t)row * NCH + ch0) = w; }
                    if (m == 3 && fr >= 14) { float* hp = halo + ((size_t)((row >> 6) * 4 + (fr - 12)) * 2) * NCH + chn; *(f32x4*)hp = g; *(f32x4*)(hp + NCH) = uu; }
                    pg = g; pu = uu;
                }
            }
        }
    }
};
struct EpiGlu {
    static constexpr bool PERM = true, AFTER_DRAIN = false;
    const float* g; const float* bias; bf16_t* O; int ldc, coff;
    __device__ __forceinline__ void operator()(const f32x4 (&acc)[2][2][4][2], const Unit& u, int wr, int wc, int fr, int fq) const {
        epi_lane(fr, fq);
        const int row0 = u.pm * BM + wr * 64 + fr, col0 = u.pn * BM + wc * 32 + 8 * fq;
        f32x4 bv[2][2];
#pragma unroll
        for (int bj = 0; bj < 2; ++bj) { bv[bj][0] = *(const f32x4*)(bias + col0 + bj * HALF); bv[bj][1] = *(const f32x4*)(bias + col0 + bj * HALF + 4); }
#pragma unroll
        for (int bj = 0; bj < 2; ++bj) {
            f32x4 g0[8], g1[8];
#pragma unroll
            for (int r = 0; r < 8; ++r) { const unsigned goff = (unsigned)(row0 + (r >> 2) * HALF + (r & 3) * 16) * 1024u + (unsigned)(col0 + bj * HALF); g0[r] = *(const f32x4*)(g + goff); g1[r] = *(const f32x4*)(g + goff + 4); }
#pragma unroll
            for (int r = 0; r < 8; ++r) { const int row = row0 + (r >> 2) * HALF + (r & 3) * 16;
                const f32x4 a0 = acc[r >> 2][bj][r & 3][0] + bv[bj][0], a1 = acc[r >> 2][bj][r & 3][1] + bv[bj][1];
                f32x4 v0, v1;
#pragma unroll
                for (int e = 0; e < 4; ++e) { v0[e] = g0[r][e] * sigmoid_f(a0[e]); v1[e] = g1[r][e] * sigmoid_f(a1[e]); }
                u32x4 w; w.x = pk2(v0[0], v0[1]); w.y = pk2(v0[2], v0[3]); w.z = pk2(v1[0], v1[1]); w.w = pk2(v1[2], v1[3]);
                *(u32x4*)(O + (size_t)row * ldc + coff + col0 + bj * HALF) = w; }
        }
    }
};
template <class Epi, class Sched, bool ALIGN_EPI = false, bool SP2 = false>
__device__ __forceinline__ void gemm_phase(PG8_LAS unsigned char* lds, const Gemm g, const Sched& S, const Epi& E, const int tid_in) {
    const int tid = tid_in, wid = __builtin_amdgcn_readfirstlane(tid >> 6), lane = tid & 63, wr = wid >> 2, wc = wid & 3, fr = lane & 15, fq = lane >> 4;
    const int K = g.K, nt = K / BK;
    unsigned voffA[2], voffB[2];
#pragma unroll
    for (int i = 0; i < 2; ++i) { int R, C; stage_rc(tid * 16 + i * 8192, R, C); const int Rb = Epi::PERM ? ((R & ~31) + perm32(R & 31)) : R;
        voffA[i] = (unsigned)(R * K + C) * 2u; voffB[i] = (unsigned)(Rb * K + C) * 2u; }
    const size_t kstep = (size_t)(BK * 2);
    const size_t hstep = (size_t)HALF * K * 2;
    const size_t tstep = 2 * hstep;
    const unsigned ldsw = (unsigned)wid * 1024u;
    const int aoff = lds_byte(wr * 64 + fr, fq * 8), boff = lds_byte(wc * 32 + fr, fq * 8);
#define PG8_SA(b, h) (((b) * 2 + (h)) * HTB)
#define PG8_SB(b, h) ((4 + (b) * 2 + (h)) * HTB)
#define PG8_STAGE(bufoff, gbase, voff) do { _Pragma("unroll") for (int _i = 0; _i < 2; ++_i) \
        __builtin_amdgcn_global_load_lds((const unsigned*)((const char*)(gbase) + (voff)[_i]), (PG8_LAS unsigned*)(lds + (bufoff) + ldsw + _i * 8192), 16, 0, 0); } while (0)
#define PG8_LDA(dst, b, h) do { _Pragma("unroll") for (int m = 0; m < 4; ++m) _Pragma("unroll") for (int k = 0; k < 2; ++k) dst[m][k] = *(const PG8_LAS bf16x8*)(lds + PG8_SA(b, h) + aoff + m * 2048 + k * 1024); } while (0)
#define PG8_LDB(dst, b, h) do { _Pragma("unroll") for (int n = 0; n < 2; ++n) _Pragma("unroll") for (int k = 0; k < 2; ++k) dst[n][k] = *(const PG8_LAS bf16x8*)(lds + PG8_SB(b, h) + boff + n * 2048 + k * 1024); } while (0)
#define PG8_MMA(ai, bj, At, Bt) do { __builtin_amdgcn_s_setprio(1); _Pragma("unroll") for (int m = 0; m < 4; ++m) _Pragma("unroll") for (int n = 0; n < 2; ++n) _Pragma("unroll") for (int k = 0; k < 2; ++k) \
        acc[ai][bj][m][n] = __builtin_amdgcn_mfma_f32_16x16x32_bf16(Bt[n][k], At[m][k], acc[ai][bj][m][n], 0, 0, 0); __builtin_amdgcn_s_setprio(0); } while (0)
#define PG8_WAIT_V(n) asm volatile("s_waitcnt vmcnt(" #n ")" ::: "memory")
#define PG8_WAIT_L(n) asm volatile("s_waitcnt lgkmcnt(" #n ")" ::: "memory")
#define PG8_BAR __builtin_amdgcn_s_barrier()
#define PG8_SCHED __builtin_amdgcn_sched_barrier(0)
    Unit cur, nxt; int ui = 0;
    if (!S.next(0, cur)) return;
    f32x4 acc[2][2][4][2];
#pragma unroll
    for (int a = 0; a < 2; ++a)
#pragma unroll
        for (int b = 0; b < 2; ++b)
#pragma unroll
            for (int m = 0; m < 4; ++m)
#pragma unroll
                for (int n = 0; n < 2; ++n) acc[a][b][m][n] = (f32x4){0.f, 0.f, 0.f, 0.f};
    bf16x8 At[4][2], B0[2][2], B1[2][2];
    const char* cA = (const char*)g.A + (size_t)cur.pm * tstep; const char* cB = (const char*)g.Bt + (size_t)cur.pn * tstep;
    S.a_ready(cur);
    if constexpr (SP2) {
        PG8_STAGE(PG8_SB(0, 0), cB, voffB); PG8_STAGE(PG8_SB(0, 1), cB + hstep, voffB); PG8_STAGE(PG8_SA(0, 0), cA, voffA); PG8_STAGE(PG8_SA(0, 1), cA + hstep, voffA);
        if (wr == 1) PG8_BAR;
        PG8_WAIT_V(2); PG8_BAR;
        PG8_STAGE(PG8_SB(1, 0), cB + kstep, voffB); PG8_STAGE(PG8_SA(1, 0), cA + kstep, voffA); PG8_STAGE(PG8_SB(1, 1), cB + hstep + kstep, voffB);
        PG8_WAIT_V(6); PG8_BAR;
    } else {
        PG8_STAGE(PG8_SB(0, 0), cB, voffB); PG8_STAGE(PG8_SA(0, 0), cA, voffA); PG8_STAGE(PG8_SB(0, 1), cB + hstep, voffB); PG8_STAGE(PG8_SA(0, 1), cA + hstep, voffA);
        if (wr == 1) PG8_BAR;
        PG8_WAIT_V(4); PG8_BAR;
        PG8_STAGE(PG8_SB(1, 0), cB + kstep, voffB); PG8_STAGE(PG8_SA(1, 0), cA + kstep, voffA); PG8_STAGE(PG8_SB(1, 1), cB + hstep + kstep, voffB);
        PG8_WAIT_V(6); PG8_BAR;
    }
    for (;;) {
        const bool has_next = S.next(ui + 1, nxt);
        const char* nA = has_next ? (const char*)g.A + (size_t)nxt.pm * tstep : cA; const char* nB = has_next ? (const char*)g.Bt + (size_t)nxt.pn * tstep : cB;
        for (int t = 0; t < nt; t += 2) {
            const bool last = (t == nt - 2);
            const char* a1 = cA + (size_t)(t + 1) * kstep;
            const char* a2 = last ? nA : cA + (size_t)(t + 2) * kstep; const char* b2 = last ? nB : cB + (size_t)(t + 2) * kstep;
            const char* a3 = a2 + kstep; const char* b3 = b2 + kstep;
            if (last && has_next) S.a_ready(nxt);
            if constexpr (SP2) {
            PG8_LDB(B0, 0, 0); PG8_LDB(B1, 0, 1); PG8_SCHED; PG8_LDA(At, 0, 0); PG8_STAGE(PG8_SA(1, 1), a1 + hstep, voffA);
            PG8_WAIT_V(8); PG8_WAIT_L(0); PG8_BAR; PG8_MMA(0, 0, At, B0); PG8_MMA(0, 1, At, B1); PG8_BAR; PG8_SCHED;
            PG8_LDA(At, 0, 1); PG8_STAGE(PG8_SB(0, 0), b2, voffB); PG8_STAGE(PG8_SB(0, 1), b2 + hstep, voffB); PG8_STAGE(PG8_SA(0, 0), a2, voffA);
            PG8_WAIT_V(8); PG8_WAIT_L(0); PG8_BAR; PG8_MMA(1, 0, At, B0); PG8_MMA(1, 1, At, B1); PG8_BAR; PG8_SCHED;
            PG8_LDB(B0, 1, 0); PG8_LDB(B1, 1, 1); PG8_SCHED; PG8_LDA(At, 1, 0); PG8_STAGE(PG8_SA(0, 1), a2 + hstep, voffA);
            PG8_WAIT_V(8); PG8_WAIT_L(0); PG8_BAR; PG8_MMA(0, 0, At, B0); PG8_MMA(0, 1, At, B1); PG8_BAR; PG8_SCHED;
            PG8_LDA(At, 1, 1); PG8_STAGE(PG8_SB(1, 0), b3, voffB); PG8_STAGE(PG8_SB(1, 1), b3 + hstep, voffB); PG8_STAGE(PG8_SA(1, 0), a3, voffA);
            PG8_WAIT_V(8); PG8_WAIT_L(0); PG8_BAR; PG8_MMA(1, 0, At, B0); PG8_MMA(1, 1, At, B1); PG8_BAR; PG8_SCHED;
            } else {
            PG8_LDB(B0, 0, 0); PG8_SCHED; PG8_LDA(At, 0, 0); PG8_STAGE(PG8_SA(1, 1), a1 + hstep, voffA);
            PG8_WAIT_L(8); PG8_BAR; PG8_WAIT_L(0); PG8_MMA(0, 0, At, B0); PG8_BAR; PG8_SCHED;
            PG8_LDB(B1, 0, 1); PG8_STAGE(PG8_SB(0, 0), b2, voffB);
            PG8_BAR; PG8_WAIT_L(0); PG8_MMA(0, 1, At, B1); PG8_BAR;
            PG8_LDA(At, 0, 1); PG8_STAGE(PG8_SA(0, 0), a2, voffA);
            PG8_BAR; PG8_WAIT_L(0); PG8_MMA(1, 0, At, B0); PG8_BAR; PG8_SCHED;
            PG8_STAGE(PG8_SB(0, 1), b2 + hstep, voffB);
            PG8_WAIT_V(6); PG8_BAR; PG8_MMA(1, 1, At, B1); PG8_BAR;
            PG8_LDB(B0, 1, 0); PG8_SCHED; PG8_LDA(At, 1, 0); PG8_STAGE(PG8_SA(0, 1), a2 + hstep, voffA);
            PG8_WAIT_L(8); PG8_BAR; PG8_WAIT_L(0); PG8_MMA(0, 0, At, B0); PG8_BAR; PG8_SCHED;
            PG8_LDB(B1, 1, 1); PG8_STAGE(PG8_SB(1, 0), b3, voffB);
            PG8_BAR; PG8_WAIT_L(0); PG8_MMA(0, 1, At, B1); PG8_BAR;
            PG8_LDA(At, 1, 1); PG8_STAGE(PG8_SA(1, 0), a3, voffA);
            PG8_BAR; PG8_WAIT_L(0); PG8_MMA(1, 0, At, B0); PG8_BAR; PG8_SCHED;
            PG8_STAGE(PG8_SB(1, 1), b3 + hstep, voffB);
            PG8_WAIT_V(6); PG8_BAR; PG8_MMA(1, 1, At, B1); PG8_BAR;
            }
        }
        if constexpr (ALIGN_EPI) { if (wr == 0) PG8_BAR; }
        if constexpr (!Epi::AFTER_DRAIN) { E(acc, cur, wr, wc, fr, fq); S.done(cur); }
        if (!has_next) break;
#pragma unroll
        for (int a = 0; a < 2; ++a)
#pragma unroll
            for (int b = 0; b < 2; ++b)
#pragma unroll
                for (int m = 0; m < 4; ++m)
#pragma unroll
                    for (int n = 0; n < 2; ++n) acc[a][b][m][n] = (f32x4){0.f, 0.f, 0.f, 0.f};
        cur = nxt; cA = nA; cB = nB; ++ui;
        if constexpr (ALIGN_EPI) { if (wr == 1) PG8_BAR; }
    }
    PG8_WAIT_V(0);
    if constexpr (!ALIGN_EPI) { if (wr == 0) PG8_BAR; }
    PG8_BAR;
    if constexpr (Epi::AFTER_DRAIN) { E.fused(acc, cur, wr, wc, fr, fq, lds, wid, lane); S.done(cur); }
#undef PG8_SA
#undef PG8_SB
#undef PG8_STAGE
#undef PG8_LDA
#undef PG8_LDB
#undef PG8_MMA
#undef PG8_WAIT_V
#undef PG8_WAIT_L
#undef PG8_BAR
#undef PG8_SCHED
}
}

constexpr int DM = 4096, BATCH = 2, SEQ = 4096, DEPTH = 4, M = BATCH * SEQ;
constexpr int HD = 128, A_HEADS = 16, A_KVH = 4, WINDOW = 128;
constexpr int A_Q = A_HEADS * HD, A_KV = A_KVH * HD, EVEN_IN = 4096, EVEN_OUT = 3072;
constexpr int S5_W = 1024, S5_P = 16, S5_NG = 64, S5_N = 64;
constexpr int C_HEADS = 16, C_W = 2048, ODD_IN = 10240, ODD_OUT = 4096;
constexpr int LRU_W = 2048, LRU_NB = 16, LRU_BD = 128;
constexpr int DFF = 10240, PLE = 256;
constexpr int NWAVES = 8, NTHREADS = NWAVES * 64;
constexpr int CHUNK = 64, NCHUNK = SEQ / CHUNK;
static_assert(M == pg8::MROWS, "rows");

constexpr size_t MiB = 1u << 20;
constexpr size_t WS_CTL = 0, CTL_ZERO_BYTES = 1 * MiB;
constexpr size_t WS_W_ABIN  = 1 * MiB;
constexpr size_t WS_W_ABOUT = WS_W_ABIN  + 2 * (size_t)EVEN_IN * DM * 2;
constexpr size_t WS_W_CDIN  = WS_W_ABOUT + 2 * (size_t)DM * EVEN_OUT * 2;
constexpr size_t WS_W_CDOUT = WS_W_CDIN  + 2 * (size_t)ODD_IN * DM * 2;
constexpr size_t WS_W_UP    = WS_W_CDOUT + 2 * (size_t)DM * ODD_OUT * 2;
constexpr size_t WS_W_DOWN  = WS_W_UP    + 4 * (size_t)(2 * DFF) * DM * 2;
constexpr size_t WS_W_GATE  = WS_W_DOWN  + 4 * (size_t)DM * DFF * 2;
constexpr size_t WS_W_PROJ  = WS_W_GATE  + 4 * (size_t)DM * DM * 2;
constexpr size_t WS_W_GLU   = WS_W_PROJ  + 4 * (size_t)DM * PLE * 2;
constexpr size_t WS_W_LRU   = WS_W_GLU   + 2 * (size_t)S5_W * S5_W * 2;
constexpr size_t WS_PB      = WS_W_LRU   + 2 * 2 * (size_t)LRU_BD * LRU_W * 2;
constexpr size_t WS_ROPE    = WS_PB      + (size_t)DEPTH * M * PLE * 2;
constexpr size_t WS_S5A     = WS_ROPE    + (size_t)M * 32 * 4;
constexpr size_t WS_S5B     = WS_S5A     + 2 * (size_t)4096 * 2 * 4;
constexpr size_t WS_H0      = WS_S5B     + 2 * (size_t)4096 * 32 * 4;
constexpr size_t WS_H1      = WS_H0      + (size_t)M * DM * 4;
constexpr size_t WS_HB0     = WS_H1      + (size_t)M * DM * 4;
constexpr size_t WS_HB1     = WS_HB0     + (size_t)M * DM * 2;
constexpr size_t WS_SSQ0    = WS_HB1     + (size_t)M * DM * 2;
constexpr size_t WS_SSQ1    = WS_SSQ0    + (size_t)64 * M * 4;
constexpr size_t WS_PROJ    = WS_SSQ1    + (size_t)64 * M * 4;
constexpr size_t WS_CAT     = WS_PROJ    + (size_t)M * ODD_IN * 2;
constexpr size_t WS_ACT     = WS_CAT     + (size_t)M * ODD_OUT * 2;
constexpr size_t WS_HALO    = WS_ACT     + (size_t)M * DFF * 2;
constexpr size_t WS_PE      = WS_HALO    + (size_t)(M / 64) * 4 * 2 * DFF * 4;
constexpr size_t WS_GF      = WS_PE      + (size_t)M * DM * 2;
constexpr size_t WS_GB      = WS_GF      + (size_t)M * S5_W * 4;
constexpr size_t WS_S5H     = WS_GB      + (size_t)M * S5_W * 2;
constexpr size_t WS_LGA     = WS_S5H     + (size_t)BATCH * S5_NG * NCHUNK * S5_N * 2 * 4;
constexpr size_t WS_LGX     = WS_LGA     + (size_t)M * LRU_W * 4;
constexpr size_t WS_LSUM    = WS_LGX     + (size_t)M * LRU_W * 4;
constexpr size_t WS_END     = WS_LSUM    + (size_t)BATCH * NCHUNK * LRU_W * 2 * 4;
static_assert(WS_W_ABIN % 256 == 0 && WS_H0 % 256 == 0 && WS_PROJ % 256 == 0 && WS_LSUM % 256 == 0, "alignment");
constexpr int CW_BAR = 4096, CW_SWA = 16384;

constexpr int RING_OFF = 0, RING_BYTES = 131072;
constexpr int MISC_OFF = 147456 - 512;
constexpr int LDS_BYTES = 147456;

#define GAS __attribute__((address_space(1)))
#define LAS __attribute__((address_space(3)))
typedef unsigned short bf16;
typedef unsigned v4u __attribute__((ext_vector_type(4)));
typedef unsigned v2u __attribute__((ext_vector_type(2)));
typedef float f32x4 __attribute__((ext_vector_type(4)));
typedef float f32x16 __attribute__((ext_vector_type(16)));
typedef short bf16x8 __attribute__((ext_vector_type(8)));
typedef short s16x4 __attribute__((ext_vector_type(4)));
typedef float f32x2w __attribute__((ext_vector_type(2)));
using pg8::pk2; using pg8::bflo; using pg8::bfhi; using pg8::sigmoid_f; using pg8::swz_xor; using pg8::add_xor32; using pg8::max_xor32; using pg8::other_xor32;
#define LDS_WAIT() asm volatile("s_waitcnt lgkmcnt(0)" ::: "memory")
__device__ __forceinline__ float bf2f(short s) { return __uint_as_float(((unsigned)(unsigned short)s) << 16); }
__device__ __forceinline__ short f2bfs(float a) { return (short)(pk2(a, 0.f) & 0xffffu); }
__device__ __forceinline__ float opaque_f(float v) { asm volatile("" : "+v"(v)); return v; }
__device__ __forceinline__ float gelu_tanh(float x, float half) {
    const float y = 0.7978845608028654f * (x + 0.044715f * x * x * x);
    const float t = 1.0f - 2.0f * __builtin_amdgcn_rcpf(__expf(2.0f * y) + 1.0f);
    return (half * x) * (1.0f + t);
}
#define XB_TMO      128
#define XB_XCNT(j)  (256  + 64 * (j))
#define XB_XSUB(j)  (1280 + 64 * (j))
#define XB_XGEN(j)  (2304 + 64 * (j))
#define XB_TOP      3328
#define XB_TOPGEN   3392
#define XCD_BAR_WORDS 3456
#define XB_SPIN_CAP (1u << 18)

__device__ __forceinline__ unsigned xb_ld(unsigned* p)              { return __hip_atomic_load(p, __ATOMIC_RELAXED, __HIP_MEMORY_SCOPE_AGENT); }
__device__ __forceinline__ unsigned xb_add(unsigned* p, unsigned v) { return __hip_atomic_fetch_add(p, v, __ATOMIC_RELAXED, __HIP_MEMORY_SCOPE_AGENT); }
__device__ __forceinline__ unsigned xb_xcc_id() { return (unsigned)__builtin_amdgcn_s_getreg((3 << 11) | 20) & 0xFu; }
#define XB_SPIN(cond, bar) do { unsigned _sp = 0; while (cond) { __builtin_amdgcn_s_sleep(1); \
    if ((++_sp & 255u) == 0u) { if (xb_ld(&(bar)[XB_TMO])) break; if (_sp > XB_SPIN_CAP) { atomicAdd(&(bar)[XB_TMO], 1u); break; } } } } while (0)

struct XcdBarrier {
    unsigned* bar; unsigned x;
    volatile LAS unsigned* st;
};

__device__ __forceinline__ XcdBarrier xcd_barrier_post(unsigned* bar, volatile LAS unsigned* st) {
    XcdBarrier b; b.bar = bar; b.x = xb_xcc_id(); b.st = st;
    if (threadIdx.x == 0) (void)xb_add(&bar[XB_XCNT(b.x)], 1u);
    return b;
}
__device__ __forceinline__ void xcd_barrier_complete(unsigned* bar, unsigned x, unsigned& nloc, unsigned& nx) {
    const unsigned G = gridDim.x * gridDim.y * gridDim.z;
    unsigned sum, cnt, mine, sp = 0u;
    for (;;) {
        sum = 0u; cnt = 0u; mine = 0u;
#pragma unroll
        for (unsigned j = 0; j < 16; ++j) { const unsigned c = xb_ld(&bar[XB_XCNT(j)]); sum += c; cnt += (c > 0u) ? 1u : 0u; mine = (j == x) ? c : mine; }
        if (sum == G) break;
        __builtin_amdgcn_s_sleep(1);
        if ((++sp & 255u) == 0u) { if (xb_ld(&bar[XB_TMO])) break; if (sp > XB_SPIN_CAP) { atomicAdd(&bar[XB_TMO], 1u); break; } }
    }
    nloc = mine > 0u ? mine : 1u; nx = cnt > 0u ? cnt : 1u;
}

__device__ __forceinline__ void xcd_barrier(const XcdBarrier& b) {
    asm volatile("s_waitcnt vmcnt(0)" ::: "memory");
    __syncthreads();
    if (threadIdx.x == 0) {
        unsigned* bar = b.bar;
        __builtin_amdgcn_s_waitcnt(0);
        unsigned nloc = b.st[0], nx = b.st[1];
        if (nloc == 0u) { xcd_barrier_complete(bar, b.x, nloc, nx); b.st[0] = nloc; b.st[1] = nx; }
        const unsigned old = xb_add(&bar[XB_XSUB(b.x)], 1u);
        const unsigned gen = old / nloc;
        if (old + 1u == (gen + 1u) * nloc) {
            __builtin_amdgcn_fence(__ATOMIC_RELEASE, "agent");
            asm volatile("s_waitcnt vmcnt(0)" ::: "memory");
            const unsigned og = xb_add(&bar[XB_TOP], 1u);
            const unsigned tg = og / nx;
            if (og + 1u == (tg + 1u) * nx) xb_add(&bar[XB_TOPGEN], 1u);
            else XB_SPIN(xb_ld(&bar[XB_TOPGEN]) == tg, bar);
            __builtin_amdgcn_fence(__ATOMIC_ACQUIRE, "agent");
            xb_add(&bar[XB_XGEN(b.x)], 1u);
            asm volatile("s_waitcnt vmcnt(0)" ::: "memory");
        } else {
            XB_SPIN(xb_ld(&bar[XB_XGEN(b.x)]) == gen, bar);
            __builtin_amdgcn_fence(__ATOMIC_ACQUIRE, "agent");
            asm volatile("s_waitcnt vmcnt(0)" ::: "memory");
        }
    }
    __syncthreads();
}


struct Ctx {
    LAS unsigned char* lds;
    LAS unsigned char* wl;
    int tid, lane, wave;
    int gw, ngw;
    int gt, ngt;
};

__device__ __forceinline__ Ctx make_ctx(LAS unsigned char* lds_base, int wave_id) {
    Ctx C; unsigned zero = 0u; asm volatile("" : "+s"(zero));
    const int lane = (int)__builtin_amdgcn_mbcnt_hi(~0u, __builtin_amdgcn_mbcnt_lo(~0u, zero));
    C.lds = lds_base; C.lane = lane; C.wave = wave_id; C.tid = wave_id * 64 + lane;
    C.wl = C.lds + RING_OFF + C.wave * 16384;
    const int G = gridDim.x;
    C.gw = blockIdx.x * NWAVES + C.wave; C.ngw = G * NWAVES; C.gt = blockIdx.x * NTHREADS + C.tid; C.ngt = G * NTHREADS;
    return C;
}
__device__ __forceinline__ unsigned char* launder_u8(unsigned char* p) { size_t z = 0; asm volatile("" : "+s"(z)); return p + z; }
#define INP(k) ((const float*)(const GAS float*)in[k])

constexpr int TP_PITCH = 66, TP_BYTES = 64 * TP_PITCH * 4;
__device__ __forceinline__ void p0_transpose_item(const float* W, int K, int N, bf16* WT, const float* gain, LAS unsigned* scr, int item, int lane, bool up_perm) {
    const int nblk = N / 64, kb = item / nblk, nb = item % nblk, k0 = 128 * kb, n0 = 64 * nb;
    const int n0d = !up_perm ? n0 : (n0 < DFF ? (n0 / 128) * 256 + (n0 % 128) : ((n0 - DFF) / 128) * 256 + 128 + ((n0 - DFF) % 128));
    const float* src = W + (size_t)k0 * N + n0 + lane;
    float g0 = 1.f, g1 = 1.f; if (gain) { g0 = gain[k0 + lane]; g1 = gain[k0 + 64 + lane]; }
#pragma unroll
    for (int bt = 0; bt < 4; ++bt) {
        float v[32];
#pragma unroll
        for (int i = 0; i < 32; ++i) v[i] = __builtin_nontemporal_load(src + (size_t)(32 * bt + i) * N);
#pragma unroll
        for (int i = 0; i < 16; ++i) { const int k = 32 * bt + 2 * i;
            const float ga = __uint_as_float(__builtin_amdgcn_readlane(__float_as_uint(k < 64 ? g0 : g1), k & 63)), gb = __uint_as_float(__builtin_amdgcn_readlane(__float_as_uint(k < 64 ? g0 : g1), (k + 1) & 63));
            scr[(16 * bt + i) * TP_PITCH + lane] = pk2(v[2 * i] * ga, v[2 * i + 1] * gb); }
    }
    LDS_WAIT(); asm volatile("" ::: "memory");
#pragma unroll
    for (int ps = 0; ps < 2; ++ps)
#pragma unroll
        for (int j = 0; j < 8; ++j) { const int n = (lane & 7) + 8 * j, c = (lane >> 3) + 8 * ps; const LAS unsigned* s = scr + (4 * c) * TP_PITCH + n;
            v4u o; o.x = s[0]; o.y = s[TP_PITCH]; o.z = s[2 * TP_PITCH]; o.w = s[3 * TP_PITCH];
            *(v4u*)(WT + (size_t)(n0d + n) * K + k0 + 8 * c) = o; }
    LDS_WAIT(); asm volatile("" ::: "memory");
}

__device__ const float ROPE_INV[16] = {
    1.000000000e+00f, 4.403665960e-01f, 1.939227432e-01f, 8.539710194e-02f, 3.760603070e-02f, 1.656044088e-02f, 7.292664610e-03f, 3.211446106e-03f,
    1.414213562e-03f, 6.227724371e-04f, 2.742481884e-04f, 1.207697351e-04f, 5.318295734e-05f, 2.341999971e-05f, 1.031338525e-05f, 4.541670478e-06f };

__device__ __forceinline__ void sincos_acc(float ang, float& s, float& c) {
    double r = (double)ang * 0.15915494309189535;
    r -= __builtin_rint(r);
    const float rf = (float)r;
    s = __builtin_amdgcn_sinf(rf); c = __builtin_amdgcn_cosf(rf);
}

__device__ __forceinline__ void p0_prologue(const Ctx& C, const float* const* in, unsigned char* ws) {
    LAS unsigned* scr = (LAS unsigned*)(C.lds + C.wave * TP_BYTES);
    {
        constexpr int I_ABIN = (DM / 128) * (EVEN_IN / 64), I_ABOUT = (EVEN_OUT / 128) * (DM / 64), I_CDIN = (DM / 128) * (ODD_IN / 64), I_CDOUT = (ODD_OUT / 128) * (DM / 64);
        constexpr int I_UP = (DM / 128) * (2 * DFF / 64), I_DOWN = (DFF / 128) * (DM / 64), I_GATE = (DM / 128) * (DM / 64), I_PROJ = (PLE / 128) * (DM / 64);
        constexpr int I_GLU = (S5_W / 128) * (S5_W / 64), I_LRU = (LRU_W / 128) * (LRU_BD / 64);
        constexpr int NITEMS = 2 * (I_ABIN + I_ABOUT + I_CDIN + I_CDOUT + I_GLU + 2 * I_LRU) + 4 * (I_UP + I_DOWN + I_GATE + I_PROJ);
        for (int it = C.gw; it < NITEMS; it += C.ngw) {
            int r = it; const float* src; bf16* dst; const float* gain = nullptr; int K, N, idx; bool up_perm = false;
            if (r < 4 * I_UP) { idx = r / I_UP; r -= idx * I_UP; K = DM; N = 2 * DFF; src = INP(29) + (size_t)idx * DM * 2 * DFF; dst = (bf16*)(ws + WS_W_UP) + (size_t)idx * 2 * DFF * DM; gain = INP(4) + idx * DM; up_perm = true; }
            else { r -= 4 * I_UP;
            if (r < 4 * I_DOWN) { idx = r / I_DOWN; r -= idx * I_DOWN; K = DFF; N = DM; src = INP(32) + (size_t)idx * DFF * DM; dst = (bf16*)(ws + WS_W_DOWN) + (size_t)idx * DM * DFF; }
            else { r -= 4 * I_DOWN;
            if (r < 4 * I_GATE) { idx = r / I_GATE; r -= idx * I_GATE; K = DM; N = DM; src = INP(33) + (size_t)idx * DM * DM; dst = (bf16*)(ws + WS_W_GATE) + (size_t)idx * DM * DM; gain = INP(5) + idx * DM; }
            else { r -= 4 * I_GATE;
            if (r < 4 * I_PROJ) { idx = r / I_PROJ; r -= idx * I_PROJ; K = PLE; N = DM; src = INP(34) + (size_t)idx * PLE * DM; dst = (bf16*)(ws + WS_W_PROJ) + (size_t)idx * DM * PLE; }
            else { r -= 4 * I_PROJ;
            if (r < 2 * I_CDIN) { idx = r / I_CDIN; r -= idx * I_CDIN; K = DM; N = ODD_IN; src = INP(20) + (size_t)idx * DM * ODD_IN; dst = (bf16*)(ws + WS_W_CDIN) + (size_t)idx * ODD_IN * DM; gain = INP(3) + (2 * idx + 1) * DM; }
            else { r -= 2 * I_CDIN;
            if (r < 2 * I_ABIN) { idx = r / I_ABIN; r -= idx * I_ABIN; K = DM; N = EVEN_IN; src = INP(7) + (size_t)idx * DM * EVEN_IN; dst = (bf16*)(ws + WS_W_ABIN) + (size_t)idx * EVEN_IN * DM; gain = INP(3) + (2 * idx) * DM; }
            else { r -= 2 * I_ABIN;
            if (r < 2 * I_ABOUT) { idx = r / I_ABOUT; r -= idx * I_ABOUT; K = EVEN_OUT; N = DM; src = INP(8) + (size_t)idx * EVEN_OUT * DM; dst = (bf16*)(ws + WS_W_ABOUT) + (size_t)idx * DM * EVEN_OUT; }
            else { r -= 2 * I_ABOUT;
            if (r < 2 * I_CDOUT) { idx = r / I_CDOUT; r -= idx * I_CDOUT; K = ODD_OUT; N = DM; src = INP(21) + (size_t)idx * ODD_OUT * DM; dst = (bf16*)(ws + WS_W_CDOUT) + (size_t)idx * DM * ODD_OUT; }
            else { r -= 2 * I_CDOUT;
            if (r < 2 * I_GLU) { idx = r / I_GLU; r -= idx * I_GLU; K = S5_W; N = S5_W; src = INP(18) + (size_t)idx * S5_W * S5_W; dst = (bf16*)(ws + WS_W_GLU) + (size_t)idx * S5_W * S5_W; }
            else { r -= 2 * I_GLU;
                idx = r / I_LRU; r -= idx * I_LRU; K = LRU_W; N = LRU_BD; src = ((idx & 1) ? INP(26) : INP(24)) + (size_t)(idx >> 1) * LRU_W * LRU_BD; dst = (bf16*)(ws + WS_W_LRU) + (size_t)idx * LRU_BD * LRU_W; }
            }}}}}}}}
            p0_transpose_item(src, K, N, dst, gain, scr, r, C.lane, up_perm);
        }
    }
    {
        const float* x = INP(0); bf16* hb = (bf16*)(ws + WS_HB0); float* ssq = (float*)(ws + WS_SSQ0);
        for (int m = C.gw; m < M; m += C.ngw) {
            const f32x4* xr = (const f32x4*)(x + (size_t)m * DM) + C.lane;
            f32x4 xv[16];
#pragma unroll
            for (int j = 0; j < 16; ++j) xv[j] = xr[64 * j];
            asm volatile("" :: "v"(xv[0]), "v"(xv[1]), "v"(xv[2]), "v"(xv[3]), "v"(xv[4]), "v"(xv[5]), "v"(xv[6]), "v"(xv[7]), "v"(xv[8]), "v"(xv[9]), "v"(xv[10]), "v"(xv[11]), "v"(xv[12]), "v"(xv[13]), "v"(xv[14]), "v"(xv[15]));
#pragma unroll
            for (int j = 0; j < 16; ++j) { const f32x4 v = xv[j];
                float s = (v[0] * v[0] + v[1] * v[1]) + (v[2] * v[2] + v[3] * v[3]);
                s += swz_xor<1>(s); s += swz_xor<2>(s); s += swz_xor<4>(s); s += swz_xor<8>(s);
                if ((C.lane & 15) == 0) ssq[(size_t)m * 64 + j * 4 + (C.lane >> 4)] = s;
                v2u o; o.x = pk2(v[0], v[1]); o.y = pk2(v[2], v[3]);
                *(v2u*)(hb + (size_t)m * DM + 256 * j + 4 * C.lane) = o; }
        }
    }
    {
        const f32x4* p4 = (const f32x4*)INP(1); v2u* o = (v2u*)(ws + WS_PB);
        for (int i = C.gt; i < DEPTH * M * PLE / 4; i += C.ngt) { const f32x4 v = p4[i]; v2u w; w.x = pk2(v[0], v[1]); w.y = pk2(v[2], v[3]); o[i] = w; }
    }
    {
        const int* pos = (const int*)INP(2); float* tab = (float*)(ws + WS_ROPE);
        for (int e = C.gt; e < M * 16; e += C.ngt) { const int row = e >> 4, i = e & 15; const float ang = (float)pos[row] * ROPE_INV[i];
            float s, c; sincos_acc(ang, s, c); tab[row * 32 + i] = c; tab[row * 32 + 16 + i] = s; }
    }
    {
        for (int e = C.gt; e < 2 * S5_NG * S5_N; e += C.ngt) { const int j = e >> 12, gn = e & 4095, g = gn >> 6;
            const float dt = expf(INP(12)[j * S5_NG + g]);
            const float lr = fminf(INP(10)[j * 4096 + gn], -1e-4f), li = INP(11)[j * 4096 + gn];
            const float mag = expf(lr * dt); float sn, cs; sincos_acc(li * dt, sn, cs);
            const float ab_re = mag * cs, ab_im = mag * sn, nr = ab_re - 1.0f, ni = ab_im, den = lr * lr + li * li;
            const float f_re = (nr * lr + ni * li) / den, f_im = (ni * lr - nr * li) / den;
            float* ta = (float*)(ws + WS_S5A) + (size_t)e * 2; ta[0] = ab_re; ta[1] = ab_im;
            float* tb = (float*)(ws + WS_S5B) + (size_t)e * 32;
            const f32x4* br = (const f32x4*)(INP(13) + (size_t)e * 16); const f32x4* bi = (const f32x4*)(INP(14) + (size_t)e * 16);
            f32x4 vr[4], vi[4];
#pragma unroll
            for (int q = 0; q < 4; ++q) { vr[q] = br[q]; vi[q] = bi[q]; }
#pragma unroll
            for (int q = 0; q < 4; ++q) { *(f32x4*)(tb + 4 * q) = f_re * vr[q] - f_im * vi[q]; *(f32x4*)(tb + 16 + 4 * q) = f_re * vi[q] + f_im * vr[q]; }
        }
    }
}

__device__ __forceinline__ unsigned off_b(unsigned row, unsigned ch) { return 256u * row + 16u * (ch ^ (((row & 3) << 2) | ((row >> 2) & 3))); }
__device__ __forceinline__ void load_tile(const bf16* src, int ld, LAS unsigned char* dst, int lane) {
    v4u v[8];
#pragma unroll
    for (int i = 0; i < 8; ++i) { const int n = lane + 64 * i, row = n >> 4, ch = n & 15; v[i] = *(const v4u*)(src + (size_t)row * ld + ch * 8); }
#pragma unroll
    for (int i = 0; i < 8; ++i) { const int n = lane + 64 * i, row = n >> 4, ch = n & 15; *(LAS v4u*)(dst + off_b(row, ch)) = v[i]; }
}
__device__ __forceinline__ void load_tile2(const bf16* srcK, const bf16* srcV, int ld, LAS unsigned char* dstK, LAS unsigned char* dstV, int lane) {
    v4u vk[8], vv[8];
#pragma unroll
    for (int i = 0; i < 8; ++i) { const int n = lane + 64 * i, row = n >> 4, ch = n & 15; vk[i] = *(const v4u*)(srcK + (size_t)row * ld + ch * 8); vv[i] = *(const v4u*)(srcV + (size_t)row * ld + ch * 8); }
    asm volatile("" :: "v"(vk[0]), "v"(vk[1]), "v"(vk[2]), "v"(vk[3]), "v"(vk[4]), "v"(vk[5]), "v"(vk[6]), "v"(vk[7]), "v"(vv[0]), "v"(vv[1]), "v"(vv[2]), "v"(vv[3]), "v"(vv[4]), "v"(vv[5]), "v"(vv[6]), "v"(vv[7]));
#pragma unroll
    for (int i = 0; i < 8; ++i) { const int n = lane + 64 * i, row = n >> 4, ch = n & 15; *(LAS v4u*)(dstK + off_b(row, ch)) = vk[i]; *(LAS v4u*)(dstV + off_b(row, ch)) = vv[i]; }
}
__device__ __forceinline__ bf16x8 frag_row(const LAS unsigned char* t, int lane, int s) { return *(const LAS bf16x8*)(t + off_b(lane & 31, 2 * s + (lane >> 5))); }
__device__ __forceinline__ s16x4 frag_tr(const LAS unsigned char* t, int lane, int c, int ks, int tt) {
    const unsigned h = lane >> 5, blk = (lane >> 4) & 1, q = (lane & 15) >> 2, p = lane & 3;
    const unsigned a = off_b(16 * ks + 8 * tt + 4 * h + q, 4 * c + 2 * blk + (p >> 1)) + 8 * (p & 1);
    typedef short v4i16_t __attribute__((ext_vector_type(4)));
    return __builtin_bit_cast(s16x4, __builtin_amdgcn_ds_read_tr16_b64_v4i16((LAS v4i16_t*)(t + a)));
}
__device__ __forceinline__ int crow(int r, int hi) { return (r & 3) + 8 * (r >> 2) + 4 * hi; }
__device__ __forceinline__ void rope_frag(bf16x8& a, bf16x8& b, const float* cs) {
    const f32x4 c0 = *(const f32x4*)cs, c1 = *(const f32x4*)(cs + 4), s0 = *(const f32x4*)(cs + 16), s1 = *(const f32x4*)(cs + 20);
#pragma unroll
    for (int j = 0; j < 8; ++j) { const float x1 = bf2f(a[j]), x2 = bf2f(b[j]), c = j < 4 ? c0[j & 3] : c1[j & 3], s = j < 4 ? s0[j & 3] : s1[j & 3];
        a[j] = f2bfs(x1 * c - x2 * s); b[j] = f2bfs(x2 * c + x1 * s); }
}
__device__ __forceinline__ void pv_tile(f32x16 (&O)[4], const f32x16& P, const LAS unsigned char* vt, int lane) {
    bf16x8 pf[2];
#pragma unroll
    for (int s = 0; s < 2; ++s) { v4u w; w.x = pk2(P[8 * s + 0], P[8 * s + 1]); w.y = pk2(P[8 * s + 2], P[8 * s + 3]); w.z = pk2(P[8 * s + 4], P[8 * s + 5]); w.w = pk2(P[8 * s + 6], P[8 * s + 7]); pf[s] = __builtin_bit_cast(bf16x8, w); }
#pragma unroll
    for (int db = 0; db < 4; ++db)
#pragma unroll
        for (int s = 0; s < 2; ++s) { const s16x4 lo = frag_tr(vt, lane, db, s, 0), hi = frag_tr(vt, lane, db, s, 1);
            const bf16x8 vf = (bf16x8){lo[0], lo[1], lo[2], lo[3], hi[0], hi[1], hi[2], hi[3]};
            O[db] = __builtin_amdgcn_mfma_f32_32x32x16_bf16(vf, pf[s], O[db], 0, 0, 0); }
}
__device__ __forceinline__ void store_ot(const f32x16 (&O)[4], float scale, bf16* dst, int hi) {
#pragma unroll
    for (int db = 0; db < 4; ++db)
#pragma unroll
        for (int rr = 0; rr < 4; ++rr) { v2u w; w.x = pk2(O[db][4 * rr] * scale, O[db][4 * rr + 1] * scale); w.y = pk2(O[db][4 * rr + 2] * scale, O[db][4 * rr + 3] * scale);
            *(v2u*)(dst + 32 * db + 8 * rr + 4 * hi) = w; }
}

__device__ __forceinline__ void swa_unit(const Ctx& C, const bf16* proj, const float* rope, const float* sinks, bf16* cat, int b, int hq, int qt) {
    const int lane = C.lane, r32 = lane & 31, hi = lane >> 5, kvh = hq >> 2, t0 = qt * 32;
    const size_t rowq = (size_t)b * SEQ + t0 + r32;
    LAS unsigned char* kt = C.wl; LAS unsigned char* vt = C.wl + 8192;
    bf16x8 qf[8];
#pragma unroll
    for (int s = 0; s < 8; ++s) qf[s] = *(const bf16x8*)(proj + rowq * EVEN_IN + hq * HD + 16 * s + 8 * hi);
    rope_frag(qf[0], qf[1], rope + rowq * 32 + 8 * hi);
    const float SC = 0.08838834764831845f * 1.4426950408889634f;
    float m = sinks[hq] * 1.4426950408889634f, lpart = hi ? 0.f : 1.f;
    f32x16 O[4];
#pragma unroll
    for (int db = 0; db < 4; ++db)
#pragma unroll
        for (int r = 0; r < 16; ++r) O[db][r] = 0.f;
    const int tq = t0 + r32;
    for (int i = 0; i < 5; ++i) {
        const int kt0 = t0 - 128 + 32 * i; if (kt0 < 0) continue;
        const size_t rowk = (size_t)b * SEQ + kt0;
        load_tile2(proj + rowk * EVEN_IN + A_Q + kvh * HD, proj + rowk * EVEN_IN + A_Q + A_KV + kvh * HD, EVEN_IN, kt, vt, lane);
        bf16x8 kf[8];
#pragma unroll
        for (int s = 0; s < 8; ++s) kf[s] = frag_row(kt, lane, s);
        rope_frag(kf[0], kf[1], rope + (rowk + r32) * 32 + 8 * hi);
        f32x16 S;
#pragma unroll
        for (int r = 0; r < 16; ++r) S[r] = 0.f;
#pragma unroll
        for (int s = 0; s < 8; ++s) S = __builtin_amdgcn_mfma_f32_32x32x16_bf16(kf[s], qf[s], S, 0, 0, 0);
        float tmax = -INFINITY;
#pragma unroll
        for (int r = 0; r < 16; ++r) { const int key = kt0 + crow(r, hi); const bool valid = (key <= tq) && (tq - key < WINDOW); S[r] = valid ? S[r] * SC : -INFINITY; tmax = fmaxf(tmax, S[r]); }
        tmax = max_xor32(tmax);
        const float mnew = fmaxf(m, tmax), alpha = __builtin_amdgcn_exp2f(m - mnew); m = mnew;
        float psum = 0.f;
#pragma unroll
        for (int r = 0; r < 16; ++r) { S[r] = __builtin_amdgcn_exp2f(S[r] - mnew); psum += S[r]; }
        lpart = lpart * alpha + psum;
#pragma unroll
        for (int db = 0; db < 4; ++db)
#pragma unroll
            for (int r = 0; r < 16; ++r) O[db][r] *= alpha;
        pv_tile(O, S, vt, lane);
    }
    const float l = add_xor32(lpart);
    store_ot(O, 1.0f / l, cat + rowq * EVEN_OUT + hq * HD, hi);
}

#ifndef SB_EARLY_EXIT
#define SB_EARLY_EXIT 1
#endif
__device__ __forceinline__ void sb_unit(const Ctx& C, const bf16* proj, bf16* cat, int b, int h, int qt) {
    const int lane = C.lane, r32 = lane & 31, hi = lane >> 5, t0 = qt * 32;
    const size_t rowq = (size_t)b * SEQ + t0 + r32;
    LAS unsigned char* kt = C.wl; LAS unsigned char* vt = C.wl + 8192;
    bf16x8 qf[8];
#pragma unroll
    for (int s = 0; s < 8; ++s) qf[s] = *(const bf16x8*)(proj + rowq * ODD_IN + h * HD + 16 * s + 8 * hi);
    f32x16 O[4];
#pragma unroll
    for (int db = 0; db < 4; ++db)
#pragma unroll
        for (int r = 0; r < 16; ++r) O[db][r] = 0.f;
    const int tq = t0 + r32;
    float c = 0.f;
    for (int kti = qt; kti >= 0; --kti) {
        const int kt0 = kti * 32; const size_t rowk = (size_t)b * SEQ + kt0;
        load_tile2(proj + rowk * ODD_IN + C_W + h * HD, proj + rowk * ODD_IN + 2 * C_W + h * HD, ODD_IN, kt, vt, lane);
        f32x16 S;
#pragma unroll
        for (int r = 0; r < 16; ++r) S[r] = 0.f;
#pragma unroll
        for (int s = 0; s < 8; ++s) S = __builtin_amdgcn_mfma_f32_32x32x16_bf16(frag_row(kt, lane, s), qf[s], S, 0, 0, 0);
        float ls[16];
        const bool diag = (kti == qt);
#pragma unroll
        for (int r = 0; r < 16; ++r) { const float z = S[r] * 0.08838834764831845f; const bool strict = !diag || (kt0 + crow(r, hi) < tq);
            const float sp = fmaxf(z, 0.f) + __logf(1.0f + __expf(-fabsf(z)));
            ls[r] = strict ? -sp : 0.f;
            S[r] = strict ? z - sp : -INFINITY; }
        float G[4], PG[4];
#pragma unroll
        for (int g = 0; g < 4; ++g) { G[g] = (ls[4 * g] + ls[4 * g + 1]) + (ls[4 * g + 2] + ls[4 * g + 3]); PG[g] = other_xor32(G[g], hi); }
        const float T3 = G[3] + PG[3], T2 = G[2] + PG[2], T1 = G[1] + PG[1], T0 = G[0] + PG[0];
        float suf[4]; suf[3] = 0.f; suf[2] = T3; suf[1] = T3 + T2; suf[0] = (T3 + T2) + T1;
#pragma unroll
        for (int g = 0; g < 4; ++g) {
            const float b3 = c + suf[g] + (hi == 0 ? PG[g] : 0.f), b2 = b3 + ls[4 * g + 3], b1 = b2 + ls[4 * g + 2], b0 = b1 + ls[4 * g + 1];
            S[4 * g + 0] = __expf(S[4 * g + 0] + b0); S[4 * g + 1] = __expf(S[4 * g + 1] + b1); S[4 * g + 2] = __expf(S[4 * g + 2] + b2); S[4 * g + 3] = __expf(S[4 * g + 3] + b3); }
        pv_tile(O, S, vt, lane);
        c += suf[0] + T0;
#if SB_EARLY_EXIT
        if (__all(c < -110.0f)) break;
#endif
    }
    store_ot(O, 1.0f, cat + rowq * ODD_OUT + h * HD, hi);
}

constexpr int S5_XP = 132;
struct S5Coef { float ar, ai; bf16x8 bf[8]; };
__device__ __forceinline__ void s5_load_coef(const unsigned char* ws, int j, int g, int lane, S5Coef& K) {
    const float* ta = (const float*)(ws + WS_S5A) + ((size_t)(j * 4096 + g * 64 + lane)) * 2; K.ar = ta[0]; K.ai = ta[1];
    const int col = lane & 15, kq = lane >> 4;
    f32x4 va[8], vb[8];
#pragma unroll
    for (int nb = 0; nb < 8; ++nb) { const int np = 16 * nb + col;
        const float* src = (const float*)(ws + WS_S5B) + ((size_t)(j * 4096 + g * 64 + (np & 63))) * 32 + (np >= 64 ? 16 : 0) + 8 * (kq & 1);
        va[nb] = *(const f32x4*)src; vb[nb] = *(const f32x4*)(src + 4); }
    asm volatile("" :: "v"(va[0]), "v"(va[1]), "v"(va[2]), "v"(va[3]), "v"(va[4]), "v"(va[5]), "v"(va[6]), "v"(va[7]), "v"(vb[0]), "v"(vb[1]), "v"(vb[2]), "v"(vb[3]), "v"(vb[4]), "v"(vb[5]), "v"(vb[6]), "v"(vb[7]));
#pragma unroll
    for (int nb = 0; nb < 8; ++nb) { const f32x4 a = va[nb], b = vb[nb];
        v4u w; w.x = pk2(a[0], a[1]); w.y = pk2(a[2], a[3]); w.z = pk2(b[0], b[1]); w.w = pk2(b[2], b[3]);
        if (kq >= 2) { w.x = 0u; w.y = 0u; w.z = 0u; w.w = 0u; }
        K.bf[nb] = __builtin_bit_cast(bf16x8, w); }
}
__device__ __forceinline__ v4u s5_load_u1(const bf16* up, int tb, int lane) { const int r = lane & 15, kq = lane >> 4; return *(const v4u*)(up + (size_t)(16 * tb + r) * EVEN_IN + 8 * (kq & 1)); }
__device__ __forceinline__ void s5_xu_block(v4u uw, const S5Coef& K, LAS float* xs, int lane) {
    const int r = lane & 15, kq = lane >> 4;
    if (kq >= 2) { uw.x = 0u; uw.y = 0u; uw.z = 0u; uw.w = 0u; }
    const bf16x8 af = __builtin_bit_cast(bf16x8, uw);
    f32x4 c[8];
#pragma unroll
    for (int nb = 0; nb < 8; ++nb) { const f32x4 z = {0.f, 0.f, 0.f, 0.f}; c[nb] = __builtin_amdgcn_mfma_f32_16x16x32_bf16(af, K.bf[nb], z, 0, 0, 0); }
    asm volatile("s_nop 7\n\ts_nop 7\n\ts_nop 7\n\ts_nop 7\n\ts_nop 7" : "+v"(c[0]), "+v"(c[1]), "+v"(c[2]), "+v"(c[3]), "+v"(c[4]), "+v"(c[5]), "+v"(c[6]), "+v"(c[7]));
#pragma unroll
    for (int nb = 0; nb < 8; ++nb)
#pragma unroll
        for (int i = 0; i < 4; ++i) xs[(4 * kq + i) * S5_XP + 16 * nb + r] = c[nb][i];
    asm volatile("s_waitcnt lgkmcnt(0)" ::: "memory"); __builtin_amdgcn_sched_barrier(0);
}
__device__ __forceinline__ void s5_pass1(const Ctx& C, unsigned char* ws, int j) {
    const bf16* proj = (const bf16*)(ws + WS_PROJ);
    float* hend = (float*)(ws + WS_S5H);
    LAS float* xs = (LAS float*)C.wl;
    const int lane = C.lane;
    const int per = (BATCH * S5_NG * NCHUNK + C.ngw - 1) / C.ngw, u0 = C.gw * per;
    int gk = -1; S5Coef K;
    for (int u = u0; u < u0 + per && u < BATCH * S5_NG * NCHUNK; ++u) {
        const int c = u % NCHUNK, g = (u / NCHUNK) % S5_NG, b = u / (NCHUNK * S5_NG);
        if (g != gk) { s5_load_coef(ws, j, g, lane, K); gk = g; }
        float hr = 0.f, hi_ = 0.f;
        const bf16* up = proj + ((size_t)b * SEQ + c * CHUNK) * EVEN_IN + (A_Q + 2 * A_KV) + g * S5_P;
        v4u ucur = s5_load_u1(up, 0, lane);
#pragma unroll 1
        for (int tb = 0; tb < CHUNK / 16; ++tb) {
            const v4u unxt = s5_load_u1(up, tb < 3 ? tb + 1 : 3, lane);
            s5_xu_block(ucur, K, xs, lane);
#pragma unroll
            for (int tt = 0; tt < 16; ++tt) { const float xr = xs[tt * S5_XP + lane], xi = xs[tt * S5_XP + 64 + lane];
                const float nr = K.ar * hr - K.ai * hi_ + xr, ni = K.ar * hi_ + K.ai * hr + xi; hr = nr; hi_ = ni; }
            ucur = unxt;
        }
        f32x2w o = {hr, hi_};
        *(f32x2w*)(hend + ((size_t)((b * S5_NG + g) * NCHUNK + c) * S5_N + lane) * 2) = o;
    }
}
__device__ __forceinline__ void s5_pass2(const Ctx& C, unsigned char* ws, const float* const* in, int j) {
    const bf16* proj = (const bf16*)(ws + WS_PROJ);
    const float* hend = (const float*)(ws + WS_S5H);
    float* GF = (float*)(ws + WS_GF); bf16* GB = (bf16*)(ws + WS_GB);
    const int lane = C.lane; const float half = opaque_f(0.5f);
    LAS float* xs = (LAS float*)C.wl;
    LAS unsigned char* hs = C.wl + 16 * S5_XP * 4;
    const int per = (BATCH * S5_NG * NCHUNK + C.ngw - 1) / C.ngw, u0 = C.gw * per;
    int gk = -1; S5Coef K; bf16x8 cf[4]; float dsk = 0.f;
    const int p = lane & 15, kq = lane >> 4;
    for (int u = u0; u < u0 + per && u < BATCH * S5_NG * NCHUNK; ++u) {
        const int c = u % NCHUNK, g = (u / NCHUNK) % S5_NG, b = u / (NCHUNK * S5_NG);
        if (g != gk) { s5_load_coef(ws, j, g, lane, K); gk = g;
#pragma unroll
            for (int ks = 0; ks < 4; ++ks) { const int k0 = 32 * ks + 8 * kq; const bool im = k0 >= 64;
                const float* src = (im ? INP(16) : INP(15)) + ((size_t)((j * S5_NG + g) * S5_P + p)) * S5_N + (k0 & 63);
                const f32x4 a = *(const f32x4*)src, bq = *(const f32x4*)(src + 4); const float sg = im ? -1.f : 1.f;
                v4u w; w.x = pk2(sg * a[0], sg * a[1]); w.y = pk2(sg * a[2], sg * a[3]); w.z = pk2(sg * bq[0], sg * bq[1]); w.w = pk2(sg * bq[2], sg * bq[3]); cf[ks] = __builtin_bit_cast(bf16x8, w); }
            dsk = INP(17)[j * S5_W + g * S5_P + p]; }
        float pr = K.ar, pi = K.ai;
#pragma unroll
        for (int q = 0; q < 6; ++q) { const float nr = pr * pr - pi * pi, tq = pr * pi; pr = nr; pi = tq + tq; }
        float hr = 0.f, hi_ = 0.f;
        const float* he = hend + ((size_t)((b * S5_NG + g) * NCHUNK) * S5_N + lane) * 2;
        for (int c0 = 0; c0 < c; c0 += 8) {
            f32x2w e[8];
#pragma unroll
            for (int k = 0; k < 8; ++k) { const int cc = (c0 + k < c) ? c0 + k : c - 1; e[k] = *(const f32x2w*)(he + (size_t)cc * S5_N * 2); }
#pragma unroll
            for (int k = 0; k < 8; ++k) if (c0 + k < c) { const float nr = pr * hr - pi * hi_ + e[k].x, ni = pr * hi_ + pi * hr + e[k].y; hr = nr; hi_ = ni; }
        }
        const size_t row0 = (size_t)b * SEQ + c * CHUNK;
        const bf16* up = proj + row0 * EVEN_IN + (A_Q + 2 * A_KV) + g * S5_P;
        v4u ucur = s5_load_u1(up, 0, lane);
#pragma unroll 1
        for (int tb = 0; tb < CHUNK / 16; ++tb) {
            const v4u unxt = s5_load_u1(up, tb < 3 ? tb + 1 : 3, lane);
            s5_xu_block(ucur, K, xs, lane); ucur = unxt;
            unsigned short us[4];
#pragma unroll
            for (int i = 0; i < 4; ++i) us[i] = up[(size_t)(16 * tb + 4 * kq + i) * EVEN_IN + p];
#pragma unroll
            for (int tt = 0; tt < 16; ++tt) { const float xr = xs[tt * S5_XP + lane], xi = xs[tt * S5_XP + 64 + lane];
                const float nr = K.ar * hr - K.ai * hi_ + xr, ni = K.ar * hi_ + K.ai * hr + xi; hr = nr; hi_ = ni;
                const unsigned w = pk2(hr, hi_);
                *(LAS unsigned short*)(hs + tt * 256 + ((((lane >> 3)) ^ tt) << 4) + (lane & 7) * 2) = (unsigned short)(w & 0xffffu);
                *(LAS unsigned short*)(hs + tt * 256 + ((((lane >> 3) + 8) ^ tt) << 4) + (lane & 7) * 2) = (unsigned short)(w >> 16); }
            f32x4 y = {0.f, 0.f, 0.f, 0.f};
#pragma unroll
            for (int ks = 0; ks < 4; ++ks) { const int t = lane & 15;
                const bf16x8 af = *(const LAS bf16x8*)(hs + t * 256 + (((4 * ks + kq) ^ t) << 4));
                y = __builtin_amdgcn_mfma_f32_16x16x32_bf16(af, cf[ks], y, 0, 0, 0); }
#pragma unroll
            for (int i = 0; i < 4; ++i) { const int t = 16 * tb + 4 * kq + i;
                const float uu = bf2f((short)us[i]);
                const float gg = gelu_tanh(y[i] + dsk * uu, half);
                GF[(row0 + t) * S5_W + g * S5_P + p] = gg;
                GB[(row0 + t) * S5_W + g * S5_P + p] = (bf16)(pk2(gg, 0.f) & 0xffffu); }
        }
    }
}

__device__ __forceinline__ void lru_gates(const Ctx& C, unsigned char* ws, const float* const* in, int j) {
    const bf16* proj = (const bf16*)(ws + WS_PROJ);
    const bf16* wt = (const bf16*)(ws + WS_W_LRU) + (size_t)(2 * j) * LRU_BD * LRU_W;
    float* LG[2] = {(float*)(ws + WS_LGA), (float*)(ws + WS_LGX)};
    const float* cw = INP(22) + (size_t)j * 4 * LRU_W; const float* cb = INP(23) + (size_t)j * LRU_W;
    for (int u = C.gw; u < (M / 32) * LRU_NB; u += C.ngw) {
        int lane = C.lane; asm volatile("" : "+v"(lane));
        const int r32 = lane & 31, hi = lane >> 5;
        const int hb = u % LRU_NB, rt = u / LRU_NB;
        LAS unsigned char* xt = C.wl;
        LAS float* wl5 = (LAS float*)(C.wl + 35 * 256);
        { const int tloc0 = (rt * 32) % SEQ;
          v4u xv[9];
#pragma unroll
          for (int i = 0; i < 9; ++i) { const int n = lane + 64 * i, jr = n >> 4, chk = n & 15; const bool ok = (n < 35 * 16) && (tloc0 - 3 + jr >= 0);
              xv[i] = *(const v4u*)(proj + ((size_t)rt * 32 + (ok ? jr - 3 : 0)) * ODD_IN + 3 * C_W + hb * LRU_BD + chk * 8);
              if (!ok) { xv[i].x = 0u; xv[i].y = 0u; xv[i].z = 0u; xv[i].w = 0u; } }
          f32x4 wv[3];
#pragma unroll
          for (int i = 0; i < 3; ++i) { const int n = lane + 64 * i, tap = n >> 5, c4 = (n & 31) * 4;
              wv[i] = (n < 160) ? *(const f32x4*)((tap < 4 ? cw + tap * LRU_W : cb) + hb * LRU_BD + c4) : (f32x4){0.f, 0.f, 0.f, 0.f}; }
#pragma unroll
          for (int i = 0; i < 9; ++i) { const int n = lane + 64 * i, jr = n >> 4, chk = n & 15; if (n < 35 * 16) *(LAS v4u*)(xt + off_b(jr, chk)) = xv[i]; }
#pragma unroll
          for (int i = 0; i < 3; ++i) { const int n = lane + 64 * i; if (n < 160) *(LAS f32x4*)(wl5 + n * 4) = wv[i]; }
        }
        bf16x8 xf[8];
#pragma unroll
        for (int s = 0; s < 8; ++s) { const int ci = 16 * s + 8 * hi;
            float a[8];
            { const f32x4 b0 = *(const LAS f32x4*)(wl5 + 4 * 128 + ci), b1 = *(const LAS f32x4*)(wl5 + 4 * 128 + ci + 4); a[0] = b0[0]; a[1] = b0[1]; a[2] = b0[2]; a[3] = b0[3]; a[4] = b1[0]; a[5] = b1[1]; a[6] = b1[2]; a[7] = b1[3]; }
#pragma unroll
            for (int k = 0; k < 4; ++k) {
                const v4u x = *(const LAS v4u*)(xt + off_b(r32 + k, 2 * s + hi));
                const f32x4 w0 = *(const LAS f32x4*)(wl5 + k * 128 + ci), w1 = *(const LAS f32x4*)(wl5 + k * 128 + ci + 4);
                a[0] += w0[0] * bflo(x.x); a[1] += w0[1] * bfhi(x.x); a[2] += w0[2] * bflo(x.y); a[3] += w0[3] * bfhi(x.y);
                a[4] += w1[0] * bflo(x.z); a[5] += w1[1] * bfhi(x.z); a[6] += w1[2] * bflo(x.w); a[7] += w1[3] * bfhi(x.w); }
            v4u w; w.x = pk2(a[0], a[1]); w.y = pk2(a[2], a[3]); w.z = pk2(a[4], a[5]); w.w = pk2(a[6], a[7]); xf[s] = __builtin_bit_cast(bf16x8, w); }
        bf16x8 idf[2];
#pragma unroll
        for (int q = 0; q < 2; ++q) { const int jj = r32 - 16 * q - 8 * hi;
#pragma unroll
            for (int e8 = 0; e8 < 8; ++e8) idf[q][e8] = (short)(e8 == jj ? 0x3F80 : 0); }
        const float* bias_a = INP(25) + (size_t)j * LRU_W + hb * LRU_BD; const float* bias_x = INP(27) + (size_t)j * LRU_W + hb * LRU_BD;
        const float* lam = INP(28) + (size_t)j * LRU_W + hb * LRU_BD;
        float ba[4], bx[4], nl[4];
#pragma unroll
        for (int cbk = 0; cbk < 4; ++cbk) { ba[cbk] = bias_a[32 * cbk + r32]; bx[cbk] = bias_x[32 * cbk + r32]; nl[cbk] = -lam[32 * cbk + r32]; }
        const bf16* wbase = wt + (size_t)r32 * LRU_W + hb * LRU_BD + 8 * hi;
#pragma unroll
        for (int cbk = 0; cbk < 4; ++cbk) {
            f32x16 acc_a, acc_x, acc_c;
#pragma unroll
            for (int r = 0; r < 16; ++r) { acc_a[r] = 0.f; acc_x[r] = 0.f; acc_c[r] = 0.f; }
            bf16x8 wa[8], wx[8];
#pragma unroll
            for (int s = 0; s < 8; ++s) { const bf16* wn = wbase + (size_t)32 * cbk * LRU_W + 16 * s; wa[s] = *(const bf16x8*)wn; wx[s] = *(const bf16x8*)(wn + (size_t)LRU_BD * LRU_W); }
            asm volatile("" :: "v"(wa[0]), "v"(wa[1]), "v"(wa[2]), "v"(wa[3]), "v"(wa[4]), "v"(wa[5]), "v"(wa[6]), "v"(wa[7]), "v"(wx[0]), "v"(wx[1]), "v"(wx[2]), "v"(wx[3]), "v"(wx[4]), "v"(wx[5]), "v"(wx[6]), "v"(wx[7]));
#pragma unroll
            for (int s = 0; s < 8; ++s) {
                acc_a = __builtin_amdgcn_mfma_f32_32x32x16_bf16(xf[s], wa[s], acc_a, 0, 0, 0);
                acc_x = __builtin_amdgcn_mfma_f32_32x32x16_bf16(xf[s], wx[s], acc_x, 0, 0, 0); }
            acc_c = __builtin_amdgcn_mfma_f32_32x32x16_bf16(xf[2 * cbk], idf[0], acc_c, 0, 0, 0);
            acc_c = __builtin_amdgcn_mfma_f32_32x32x16_bf16(xf[2 * cbk + 1], idf[1], acc_c, 0, 0, 0);
            const float spl = fmaxf(nl[cbk], 0.f) + __logf(1.0f + __expf(-fabsf(nl[cbk])));
            LAS float* ta = (LAS float*)C.wl; LAS float* td = ta + 32 * 64;
#pragma unroll
            for (int r = 0; r < 16; ++r) {
                const float rg = sigmoid_f(acc_a[r] + ba[cbk]), ig = sigmoid_f(acc_x[r] + bx[cbk]);
                const float la = -8.0f * rg * spl, a = __expf(la), a2 = a * a;
                const float om_s = -la * (2.0f + la * (2.0f + la * (1.3333334f + la * 0.6666667f))), om_d = 1.0f - a2;
                const unsigned msk = (la > -0.05f) ? 0xffffffffu : 0u;
                const float om = __uint_as_float((__float_as_uint(om_s) & msk) | (__float_as_uint(om_d) & ~msk));
                ta[crow(r, hi) * 64 + 32 * (cbk & 1) + r32] = a; td[crow(r, hi) * 64 + 32 * (cbk & 1) + r32] = __builtin_amdgcn_sqrtf(om) * (ig * acc_c[r]); }
            if (cbk & 1) {
                float* oa = LG[0] + (size_t)rt * 32 * LRU_W + hb * LRU_BD + 64 * (cbk >> 1); float* od = LG[1] + (size_t)rt * 32 * LRU_W + hb * LRU_BD + 64 * (cbk >> 1);
#pragma unroll
                for (int i = 0; i < 8; ++i) { const int row = 4 * i + (lane >> 4), c4 = (lane & 15) * 4;
                    *(f32x4*)(oa + (size_t)row * LRU_W + c4) = *(const LAS f32x4*)(ta + row * 64 + c4);
                    *(f32x4*)(od + (size_t)row * LRU_W + c4) = *(const LAS f32x4*)(td + row * 64 + c4); }
            }
        }
    }
}
template <bool FINAL> struct LruIn { f32x2w a[16], d[16]; unsigned xg[16]; };
template <bool FINAL> __device__ __forceinline__ void lru_load(LruIn<FINAL>& I, const float* pa, const float* pd, const bf16* xgp, int t0) {
#pragma unroll
    for (int k = 0; k < 16; ++k) { I.a[k] = *(const f32x2w*)(pa + (size_t)(t0 + k) * LRU_W); I.d[k] = *(const f32x2w*)(pd + (size_t)(t0 + k) * LRU_W); if (FINAL) I.xg[k] = *(const unsigned*)(xgp + (size_t)(t0 + k) * ODD_IN); }
}
template <bool FINAL> __device__ __forceinline__ void lru_scan(const Ctx& C, unsigned char* ws, const float* const* in, int j) {
    const bf16* proj = (const bf16*)(ws + WS_PROJ);
    const float* LGA = (const float*)(ws + WS_LGA); const float* LGX = (const float*)(ws + WS_LGX);
    float* SUM = (float*)(ws + WS_LSUM); bf16* cat = (bf16*)(ws + WS_CAT);
    const float half = opaque_f(0.5f);
    for (int u = C.gw; u < BATCH * NCHUNK * (LRU_W / 128); u += C.ngw) {
        const int chg = u % (LRU_W / 128), c = (u / (LRU_W / 128)) % NCHUNK, b = u / ((LRU_W / 128) * NCHUNK), ch = chg * 128 + 2 * C.lane;
        const size_t row0 = (size_t)b * SEQ + c * CHUNK;
        const bf16* xgp = proj + row0 * ODD_IN + 3 * C_W + LRU_W + ch; const float* pa = LGA + row0 * LRU_W + ch; const float* pd = LGX + row0 * LRU_W + ch;
        float h0 = 0.f, h1 = 0.f, p0 = 1.f, p1 = 1.f;
        if (FINAL) { const float* sm = SUM + ((size_t)b * NCHUNK * LRU_W + ch) * 2;
            for (int c0 = 0; c0 < c; c0 += 16) {
                f32x4 s[16];
#pragma unroll
                for (int k = 0; k < 16; ++k) { const int cc = (c0 + k < c) ? c0 + k : c - 1; s[k] = *(const f32x4*)(sm + (size_t)cc * LRU_W * 2); }
#pragma unroll
                for (int k = 0; k < 16; ++k) if (c0 + k < c) { h0 = s[k][0] * h0 + s[k][1]; h1 = s[k][2] * h1 + s[k][3]; }
            } }
        bf16* op = cat + row0 * ODD_OUT + C_W + ch;
#pragma unroll 1
        for (int t0 = 0; t0 < CHUNK; t0 += 16) {
            LruIn<FINAL> I; lru_load<FINAL>(I, pa, pd, xgp, t0);
            unsigned o_[16];
#pragma unroll
            for (int k = 0; k < 16; ++k) { h0 = I.a[k].x * h0 + I.d[k].x; h1 = I.a[k].y * h1 + I.d[k].y; p0 *= I.a[k].x; p1 *= I.a[k].y;
                if (FINAL) o_[k] = pk2(h0 * gelu_tanh(bflo(I.xg[k]), half), h1 * gelu_tanh(bfhi(I.xg[k]), half)); }
            if (FINAL) {
#pragma unroll
                for (int k = 0; k < 16; ++k) *(unsigned*)(op + (size_t)(t0 + k) * ODD_OUT) = o_[k]; }
        }
        if (!FINAL) { f32x4 s = {p0, h0, p1, h1}; *(f32x4*)(SUM + ((size_t)(b * NCHUNK + c) * LRU_W + ch) * 2) = s; }
    }
}

__device__ __forceinline__ void ffn_fixup(const Ctx& C, unsigned char* ws, const float* const* in, int layer) {
    const float* halo = (const float*)(ws + WS_HALO); bf16* act = (bf16*)(ws + WS_ACT);
    const float* cw = INP(30) + (size_t)layer * 3 * 2 * DFF; const float* cb = INP(31) + (size_t)layer * 2 * DFF;
    for (int e = C.gt; e < (M / 64) * 2 * (DFF / 4); e += C.ngt) {
        const int ch = (e % (DFF / 4)) * 4, jr = (e / (DFF / 4)) & 1, blk = e / (2 * (DFF / 4));
        const bool has_prev = ((blk * 64) % SEQ) != 0;
        f32x4 v[2][3];
#pragma unroll
        for (int gu = 0; gu < 2; ++gu) {
            const f32x4 z = {0.f, 0.f, 0.f, 0.f};
            const f32x4 cur0 = *(const f32x4*)(halo + ((size_t)(blk * 4 + 0) * 2 + gu) * DFF + ch);
            f32x4 p3 = z, p2 = z;
            if (has_prev) { p3 = *(const f32x4*)(halo + ((size_t)((blk - 1) * 4 + 3) * 2 + gu) * DFF + ch); p2 = *(const f32x4*)(halo + ((size_t)((blk - 1) * 4 + 2) * 2 + gu) * DFF + ch); }
            if (jr == 0) { v[gu][0] = p2; v[gu][1] = p3; v[gu][2] = cur0; }
            else { v[gu][0] = p3; v[gu][1] = cur0; v[gu][2] = *(const f32x4*)(halo + ((size_t)(blk * 4 + 1) * 2 + gu) * DFF + ch); }
        }
        f32x4 o;
        const f32x4 wg0 = *(const f32x4*)(cw + ch), wg1 = *(const f32x4*)(cw + 2 * DFF + ch), wg2 = *(const f32x4*)(cw + 4 * DFF + ch), bg = *(const f32x4*)(cb + ch);
        const f32x4 wu0 = *(const f32x4*)(cw + DFF + ch), wu1 = *(const f32x4*)(cw + 3 * DFF + ch), wu2 = *(const f32x4*)(cw + 5 * DFF + ch), bu = *(const f32x4*)(cb + DFF + ch);
#pragma unroll
        for (int q = 0; q < 4; ++q) { const float gc = bg[q] + wg0[q] * v[0][0][q] + wg1[q] * v[0][1][q] + wg2[q] * v[0][2][q], uc = bu[q] + wu0[q] * v[1][0][q] + wu1[q] * v[1][1][q] + wu2[q] * v[1][2][q];
            o[q] = gc * sigmoid_f(gc) * uc; }
        v2u w; w.x = pk2(o[0], o[1]); w.y = pk2(o[2], o[3]);
        *(v2u*)(act + (size_t)(blk * 64 + jr) * DFF + ch) = w;
    }
}

__device__ __forceinline__ void final_norm(const Ctx& C, const bf16* hb, const float* ssq, const float* gain, float* out) {
    f32x4 gv[16];
#pragma unroll
    for (int jj = 0; jj < 16; ++jj) gv[jj] = ((const f32x4*)gain + C.lane)[64 * jj];
    for (int m = C.gw; m < M; m += C.ngw) {
        float s = ssq[(size_t)m * 64 + C.lane];
        s += swz_xor<1>(s); s += swz_xor<2>(s); s += swz_xor<4>(s); s += swz_xor<8>(s); s += swz_xor<16>(s); s = add_xor32(s);
        const float rs = rsqrtf(s * (1.0f / DM) + 1e-6f);
        const v2u* hr = (const v2u*)(hb + (size_t)m * DM) + C.lane; f32x4* o4 = (f32x4*)(out + (size_t)m * DM) + C.lane;
        v2u hv[16];
#pragma unroll
        for (int jj = 0; jj < 16; ++jj) hv[jj] = hr[64 * jj];
        asm volatile("" :: "v"(hv[0]), "v"(hv[1]), "v"(hv[2]), "v"(hv[3]), "v"(hv[4]), "v"(hv[5]), "v"(hv[6]), "v"(hv[7]), "v"(hv[8]), "v"(hv[9]), "v"(hv[10]), "v"(hv[11]), "v"(hv[12]), "v"(hv[13]), "v"(hv[14]), "v"(hv[15]));
#pragma unroll
        for (int jj = 0; jj < 16; ++jj) { f32x4 v; v[0] = bflo(hv[jj].x); v[1] = bfhi(hv[jj].x); v[2] = bflo(hv[jj].y); v[3] = bfhi(hv[jj].y); o4[64 * jj] = v * rs * gv[jj]; }
    }
}

struct Args { const float* in[35]; float* out; unsigned char* ws; int ph_lo, ph_hi, sub, pad; };
static_assert(sizeof(Args) == 35 * 8 + 8 + 8 + 16, "Args has no padding");

__global__ void __launch_bounds__(NTHREADS, 2) hybrid_fwd(Args args) {
    extern __shared__ __attribute__((aligned(16))) unsigned char lds_raw[];
    LAS unsigned char* const lds_base = (LAS unsigned char*)lds_raw;
    const int G = gridDim.x;
    const int wave_id = __builtin_amdgcn_readfirstlane((int)threadIdx.x >> 6);
    unsigned char* const ws_arg = args.ws;
#define ENV unsigned char* ws = launder_u8(ws_arg); const float* const* in = (const float* const*)launder_u8((unsigned char*)__builtin_amdgcn_kernarg_segment_ptr()); (void)in; (void)ws; \
    const Ctx C = make_ctx(lds_base, wave_id); (void)C
#define MISC ((volatile LAS unsigned*)(lds_base + MISC_OFF))
    for (int u = threadIdx.x; u < (LDS_BYTES - MISC_OFF) / 4; u += NTHREADS) ((LAS unsigned*)(lds_base + MISC_OFF))[u] = 0u;
    __syncthreads();
    const int lo = args.ph_lo, hi = args.ph_hi, sub = args.sub;
    const bool one_launch = (hi - lo) > 1;
    if (one_launch) (void)xcd_barrier_post((unsigned*)(ws_arg + WS_CTL) + CW_BAR, MISC + 8);
#ifndef PH_MASK
#define PH_MASK 0xffffffffu
#endif
#define PH_ON(k) ((k) == 0 ? ((PH_MASK >> 15) & 1u) : (k) == 65 ? ((PH_MASK >> 31) & 1u) : ((PH_MASK >> ((((k) - 1) & 15) + ((((k) - 1) >> 4) & 1) * 16)) & 1u))
#define IN(k) (PH_ON(k) && lo <= (k) && (k) < hi)
#define SEAM(k) do { if (hi > (k) + 1) { XcdBarrier bar_; bar_.bar = (unsigned*)(launder_u8(ws_arg) + WS_CTL) + CW_BAR; bar_.x = xb_xcc_id(); bar_.st = MISC + 8; xcd_barrier(bar_); } } while (0)
    LAS unsigned char* const ring = lds_base + RING_OFF;

    if (IN(0)) { ENV; p0_prologue(C, in, ws); SEAM(0); }

    int cur = 0;
    int hcur = 0;
#define HBP(i)  ((bf16*)(ws + WS_HB0 + (size_t)(i) * (WS_HB1 - WS_HB0)))
#define SSQP(i) ((float*)(ws + WS_SSQ0 + (size_t)(i) * (WS_SSQ1 - WS_SSQ0)))
#define HP(i)   ((float*)(ws + WS_H0 + (size_t)(i) * (WS_H1 - WS_H0)))
#define PROJ ((bf16*)(ws + WS_PROJ))
#define CAT  ((bf16*)(ws + WS_CAT))

#pragma unroll 1
    for (int layer = 0; layer < DEPTH; ++layer) {
        const int pb = 1 + 16 * layer, j = layer >> 1;
        if ((layer & 1) == 0) {
            if (IN(pb + 0)) { ENV;
                pg8::Gemm g{HBP(cur), (const bf16*)(ws + WS_W_ABIN) + (size_t)j * EVEN_IN * DM, M, EVEN_IN, DM}; pg8::StaticOrder S; S.init(M, EVEN_IN, G, (int)blockIdx.x);
                pg8::EpiRowScale<true> E{PROJ, EVEN_IN, SSQP(cur), (pg8::lds_f32*)(lds_base + RING_BYTES)};
                pg8::gemm_phase<pg8::EpiRowScale<true>, pg8::StaticOrder, true, true>(ring, g, S, E, C.tid);
                SEAM(pb + 0);
            }
            if (IN(pb + 1)) { ENV;
                s5_pass1(C, ws, j);
                SEAM(pb + 1);
            }
            if (IN(pb + 2)) { ENV; s5_pass2(C, ws, in, j); SEAM(pb + 2); }
            if (IN(pb + 3)) { ENV;
                pg8::Gemm g{(const bf16*)(ws + WS_GB), (const bf16*)(ws + WS_W_GLU) + (size_t)j * S5_W * S5_W, M, S5_W, S5_W}; pg8::StaticOrder S; S.init(M, S5_W, G, (int)blockIdx.x);
                pg8::EpiGlu E{(const float*)(ws + WS_GF), INP(19) + j * S5_W, CAT, EVEN_OUT, A_Q};
                pg8::gemm_phase<pg8::EpiGlu, pg8::StaticOrder, true, true>(ring, g, S, E, C.tid);
                if (sub != 1) { const float* rope = (const float*)(ws + WS_ROPE); const float* sinks = INP(9) + j * A_HEADS;
                    unsigned* cnt = (unsigned*)(ws + WS_CTL) + CW_SWA + 64 * j;
                    for (;;) { unsigned u = 0; if (C.lane == 0) u = __hip_atomic_fetch_add(cnt, 1u, __ATOMIC_RELAXED, __HIP_MEMORY_SCOPE_AGENT); u = __builtin_amdgcn_readfirstlane(u);
                        if (u >= (unsigned)(BATCH * A_HEADS * (SEQ / 32))) break;
                        const int qt = u % (SEQ / 32), hq = (u / (SEQ / 32)) % A_HEADS, b = u / ((SEQ / 32) * A_HEADS);
                        swa_unit(C, PROJ, rope, sinks, CAT, b, hq, qt); } }
                SEAM(pb + 3);
            }
            if (IN(pb + 4)) { ENV;
                pg8::Gemm g{CAT, (const bf16*)(ws + WS_W_ABOUT) + (size_t)j * DM * EVEN_OUT, M, DM, EVEN_OUT}; pg8::StaticOrder S; S.init(M, DM, G, (int)blockIdx.x);
                pg8::EpiResidual E{HBP(cur), HBP(cur ^ 1), SSQP(cur ^ 1)};
                pg8::gemm_phase<pg8::EpiResidual, pg8::StaticOrder, true, true>(ring, g, S, E, C.tid);
                SEAM(pb + 4);
            }
        } else {
            if (IN(pb + 0)) { ENV;
                pg8::Gemm g{HBP(cur), (const bf16*)(ws + WS_W_CDIN) + (size_t)j * ODD_IN * DM, M, ODD_IN, DM}; pg8::StaticOrder S; S.init(M, ODD_IN, G, (int)blockIdx.x);
                pg8::EpiRowScale<true> E{PROJ, ODD_IN, SSQP(cur), (pg8::lds_f32*)(lds_base + RING_BYTES)};
                pg8::gemm_phase<pg8::EpiRowScale<true>, pg8::StaticOrder, true, true>(ring, g, S, E, C.tid);
                SEAM(pb + 0);
            }
            if (IN(pb + 1)) { ENV;
                if (sub != 2) for (int u = C.gw; u < BATCH * C_HEADS * (SEQ / 64); u += C.ngw) { const int q0 = u % (SEQ / 64), bh = u / (SEQ / 64), b = bh / C_HEADS, h = bh % C_HEADS;
                    sb_unit(C, PROJ, CAT, b, h, q0); sb_unit(C, PROJ, CAT, b, h, SEQ / 32 - 1 - q0); }
                if (sub != 1) lru_gates(C, ws, in, j);
                SEAM(pb + 1);
            }
            if (IN(pb + 2)) { ENV; lru_scan<false>(C, ws, in, j); SEAM(pb + 2); }
            if (IN(pb + 3)) { ENV; lru_scan<true>(C, ws, in, j); SEAM(pb + 3); }
            if (IN(pb + 4)) { ENV;
                pg8::Gemm g{CAT, (const bf16*)(ws + WS_W_CDOUT) + (size_t)j * DM * ODD_OUT, M, DM, ODD_OUT}; pg8::StaticOrder S; S.init(M, DM, G, (int)blockIdx.x);
                pg8::EpiResidual E{HBP(cur), HBP(cur ^ 1), SSQP(cur ^ 1)};
                pg8::gemm_phase<pg8::EpiResidual, pg8::StaticOrder, true, true>(ring, g, S, E, C.tid);
                SEAM(pb + 4);
            }
        }
        cur ^= 1;
        if (IN(pb + 5)) { ENV;
            { pg8::Gemm g{HBP(cur), (const bf16*)(ws + WS_W_UP) + (size_t)layer * 2 * DFF * DM, M, 2 * DFF, DM}; pg8::StaticOrder S; S.init(M, 2 * DFF, G, (int)blockIdx.x);
              pg8::EpiUpConv E{(bf16*)(ws + WS_ACT), SSQP(cur), INP(30) + (size_t)layer * 3 * 2 * DFF, INP(31) + (size_t)layer * 2 * DFF, (float*)(ws + WS_HALO), (pg8::lds_f32*)(lds_base + RING_BYTES)};
              pg8::gemm_phase<pg8::EpiUpConv, pg8::StaticOrder, true, true>(ring, g, S, E, C.tid); }
            { ENV; pg8::Gemm g{(const bf16*)(ws + WS_PB) + (size_t)layer * M * PLE, (const bf16*)(ws + WS_W_PROJ) + (size_t)layer * DM * PLE, M, DM, PLE}; pg8::StaticOrder S; S.init(M, DM, G, (int)blockIdx.x);
              pg8::EpiRowScale<false> E{(bf16*)(ws + WS_PE), DM, nullptr, nullptr};
              pg8::gemm_phase<pg8::EpiRowScale<false>, pg8::StaticOrder, true, true>(ring, g, S, E, C.tid); }
            SEAM(pb + 5);
        }
        if (IN(pb + 6)) { ENV; ffn_fixup(C, ws, in, layer); SEAM(pb + 6); }
        if (IN(pb + 7)) { ENV;
            pg8::Gemm g{(const bf16*)(ws + WS_ACT), (const bf16*)(ws + WS_W_DOWN) + (size_t)layer * DM * DFF, M, DM, DFF}; pg8::StaticOrder S; S.init(M, DM, G, (int)blockIdx.x);
            pg8::EpiResidual E{HBP(cur), HBP(cur ^ 1), SSQP(cur ^ 1)};
            pg8::gemm_phase<pg8::EpiResidual, pg8::StaticOrder, true, true>(ring, g, S, E, C.tid);
            SEAM(pb + 7);
        }
        cur ^= 1;
        if (IN(pb + 8)) { ENV;
            pg8::Gemm g{HBP(cur), (const bf16*)(ws + WS_W_GATE) + (size_t)layer * DM * DM, M, DM, DM}; pg8::StaticOrder S; S.init(M, DM, G, (int)blockIdx.x);
            pg8::EpiGate E{HBP(cur), HBP(cur ^ 1), SSQP(cur), SSQP(cur ^ 1), (const bf16*)(ws + WS_PE), (pg8::lds_f32*)(lds_base + RING_BYTES)};
            pg8::gemm_phase<pg8::EpiGate, pg8::StaticOrder, true, true>(ring, g, S, E, C.tid);
            SEAM(pb + 8);
        }
        cur ^= 1; hcur ^= 1;
    }
    if (IN(65)) { ENV; final_norm(C, HBP(cur), SSQP(cur), INP(6), args.out); }
#undef IN
#undef SEAM
}

#ifndef MK_PER_PHASE
#define MK_PER_PHASE 0
#endif
extern "C" void kernel_launch(void* const* d_in, const int* in_sizes, int n_in, void* d_out, int out_size, void* d_ws, size_t ws_size, hipStream_t stream) {
    static int grid = 0;
    if (grid == 0) {
        if (n_in != 35 || in_sizes[0] != M * DM || out_size != M * DM || ws_size < WS_END) {
            fprintf(stderr, "kernel_launch: built for 35 inputs, x/out of %d floats, >= %zu bytes of workspace; got n_in %d, in0 %d, out %d, ws %zu; nothing launched\n", M * DM, (size_t)WS_END, n_in, n_in > 0 ? in_sizes[0] : -1, out_size, ws_size);
            grid = -1; return; }
        int dev = 0, cus = 0, per_cu = 0;
        if (hipGetDevice(&dev) != hipSuccess || hipDeviceGetAttribute(&cus, hipDeviceAttributeMultiprocessorCount, dev) != hipSuccess) { fprintf(stderr, "kernel_launch: device query failed\n"); grid = -1; return; }
        if (hipFuncSetAttribute((const void*)hybrid_fwd, hipFuncAttributeMaxDynamicSharedMemorySize, LDS_BYTES) != hipSuccess) { fprintf(stderr, "kernel_launch: hipFuncSetAttribute failed\n"); grid = -1; return; }
        if (hipOccupancyMaxActiveBlocksPerMultiprocessor(&per_cu, (const void*)hybrid_fwd, NTHREADS, LDS_BYTES) != hipSuccess || per_cu < 1)
            fprintf(stderr, "kernel_launch: note: occupancy query reports %d workgroups per CU\n", per_cu);
        (void)hipGetLastError();
        grid = cus;
    }
    if (grid < 0) return;
    if (hipMemsetAsync((char*)d_ws + WS_CTL, 0, CTL_ZERO_BYTES, stream) != hipSuccess) { fprintf(stderr, "kernel_launch: memset failed\n"); return; }
    Args a{};
    for (int i = 0; i < 35; ++i) a.in[i] = (const float*)d_in[i];
    a.out = (float*)d_out; a.ws = (unsigned char*)d_ws;
#if MK_PER_PHASE
    for (int ph = 0; ph <= 65; ++ph) {
        const int k = (ph - 1) & 15;
        if (ph != 0 && ph != 65 && k > 8) continue;
        a.ph_lo = ph; a.ph_hi = ph + 1;
        hipLaunchKernelGGL(hybrid_fwd, dim3(grid), dim3(NTHREADS), LDS_BYTES, stream, a);
#if defined(PROBE_PHASE)
#ifndef PROBE_SUB
#define PROBE_SUB 0
#endif
        if (ph == PROBE_PHASE) { a.sub = PROBE_SUB; for (int r = 0; r < PROBE_REPS; ++r) hipLaunchKernelGGL(hybrid_fwd, dim3(grid), dim3(NTHREADS), LDS_BYTES, stream, a); a.sub = 0; }
#endif
    }
#else
    a.ph_lo = 0; a.ph_hi = 66;
    hipLaunchKernelGGL(hybrid_fwd, dim3(grid), dim3(NTHREADS), LDS_BYTES, stream, a);
#endif
    const hipError_t le = hipPeekAtLastError();
    if (le != hipSuccess) fprintf(stderr, "kernel_launch: launch failed: %s\n", hipGetErrorName(le));
}
```
